# Optimizing an MI355X kernel written in HIP

```python
import math
import jax, jax.numpy as jnp
from jax import lax
import numpy as np

D_MODEL = 1024
BATCH = 8
SEQ = 2048
DEPTH = 4
DEC_BATCH = 128
DEC_SEQ = 4
PAST_LEN = 8192
PAGE_SIZE = 128

N_HEADS = 8
N_KV_HEADS = 2
HEAD_DIM = 64
GQA_GROUP = N_HEADS // N_KV_HEADS
D_ATTN = N_HEADS * HEAD_DIM
D_CONV = D_MODEL - D_ATTN
D_MIX = D_ATTN + D_CONV
D_KV = N_KV_HEADS * HEAD_DIM
D_IN = D_ATTN + 2 * D_KV + 3 * D_CONV
CONV_WIDTH = 3
WINDOW = 128
BLOCK = 128
N_META = 16
N_BUCKETS = 32
MAX_DISTANCE = 128
D_FF = 2816
DN_ALPHA = (2 * DEPTH) ** 0.25
DN_BETA = (8 * DEPTH) ** -0.25
LN_EPS = 1e-5

kernel_name = "hymba_swa_shortconv_macaron_deepnorm_step"


def layer_norm(x, g, b):
    xf = x.astype(jnp.float32)
    mu = jnp.mean(xf, axis=-1, keepdims=True)
    var = jnp.mean(jnp.square(xf - mu), axis=-1, keepdims=True)
    y = (xf - mu) * lax.rsqrt(var + LN_EPS) * g.astype(jnp.float32) + b.astype(jnp.float32)
    return y.astype(x.dtype)


def swiglu(x, wg, wu, wd):
    return (jax.nn.silu(x @ wg) * (x @ wu)) @ wd


def t5_bucket(d):
    d = jnp.maximum(d, 0)
    max_exact = N_BUCKETS // 2
    df = jnp.maximum(d, 1).astype(jnp.float32)
    large = max_exact + (jnp.log(df / max_exact) / math.log(MAX_DISTANCE / max_exact)
                         * (N_BUCKETS - max_exact)).astype(jnp.int32)
    large = jnp.minimum(large, N_BUCKETS - 1)
    return jnp.where(d < max_exact, d, large)


def rel_bias_heads(d, rel_tab):
    b = rel_tab[t5_bucket(d)].astype(jnp.float32)
    b = jnp.moveaxis(b, -1, 0)
    return b.reshape((N_KV_HEADS, GQA_GROUP) + d.shape)


def sink_softmax(s, sink):
    sk = sink.astype(jnp.float32).reshape(N_KV_HEADS, GQA_GROUP, 1, 1)
    m = jnp.maximum(jnp.max(s, axis=-1, keepdims=True), sk)
    p = jnp.exp(s - m)
    return p / (jnp.sum(p, axis=-1, keepdims=True) + jnp.exp(sk - m))


def project(x, w):
    z = x @ w
    cuts = [D_ATTN, D_ATTN + D_KV, D_ATTN + 2 * D_KV,
            D_ATTN + 2 * D_KV + D_CONV, D_ATTN + 2 * D_KV + 2 * D_CONV]
    q, k, v, bg, cg, h = jnp.split(z, cuts, axis=-1)
    lead = x.shape[:-1]
    q = q.reshape(lead + (N_HEADS, HEAD_DIM))
    k = k.reshape(lead + (N_KV_HEADS, HEAD_DIM))
    v = v.reshape(lead + (N_KV_HEADS, HEAD_DIM))
    return q, k, v, bg, cg, h


def swa_prompt(q, k, v, sink, rel_tab):
    B, L = q.shape[0], q.shape[1]
    pad = (-L) % BLOCK
    nb = (L + pad) // BLOCK
    padf = lambda t: jnp.pad(t, ((0, 0), (pad, 0), (0, 0), (0, 0)))
    qb = padf(q).reshape(B, nb, BLOCK, N_KV_HEADS, GQA_GROUP, HEAD_DIM)
    kb = padf(k).reshape(B, nb, BLOCK, N_KV_HEADS, HEAD_DIM)
    vb = padf(v).reshape(B, nb, BLOCK, N_KV_HEADS, HEAD_DIM)

    def band(t):
        prev = jnp.pad(t, ((0, 0), (1, 0), (0, 0), (0, 0), (0, 0)))[:, :nb]
        return jnp.concatenate([prev, t], axis=2)

    kk, vv = band(kb), band(vb)
    s = jnp.einsum('bnqkgd,bnskd->bnkgqs', qb, kk).astype(jnp.float32) * (HEAD_DIM ** -0.5)
    qi = jnp.arange(BLOCK)
    sj = jnp.arange(2 * BLOCK)
    d = qi[:, None] + BLOCK - sj[None, :]
    key_idx = (jnp.arange(nb)[:, None] - 1) * BLOCK + sj[None, :]
    valid = ((d >= 0) & (d <= WINDOW))[None] & (key_idx >= pad)[:, None, :]
    s = jnp.where(valid[None, :, None, None], s + rel_bias_heads(d, rel_tab), -jnp.inf)
    p = sink_softmax(s, sink).astype(vv.dtype)
    o = jnp.einsum('bnkgqs,bnskd->bnqkgd', p, vv).reshape(B, nb * BLOCK, D_ATTN)[:, pad:]
    return o, k[:, -WINDOW:], v[:, -WINDOW:]


def swa_sample(q, k, v, k_buf, v_buf, sink, rel_tab):
    B, T = q.shape[0], q.shape[1]
    W = k_buf.shape[1]
    kk = jnp.concatenate([k_buf.astype(k.dtype), k], axis=1)
    vv = jnp.concatenate([v_buf.astype(v.dtype), v], axis=1)
    qg = q.reshape(B, T, N_KV_HEADS, GQA_GROUP, HEAD_DIM)
    s = jnp.einsum('btkgd,bskd->bkgts', qg, kk).astype(jnp.float32) * (HEAD_DIM ** -0.5)
    d = jnp.arange(T)[:, None] + W - jnp.arange(W + T)[None, :]
    valid = (d >= 0) & (d <= WINDOW)
    s = jnp.where(valid, s + rel_bias_heads(d, rel_tab), -jnp.inf)
    p = sink_softmax(s, sink).astype(vv.dtype)
    o = jnp.einsum('bkgts,bskd->btkgd', p, vv).reshape(B, T, D_ATTN)
    return o, kk[:, -WINDOW:], vv[:, -WINDOW:]


def short_conv(u, prev, w):
    T = u.shape[1]
    full = jnp.concatenate([prev.astype(u.dtype), u], axis=1)
    out = sum(w[j] * full[:, j:j + T] for j in range(CONV_WIDTH))
    return out, full[:, -(CONV_WIDTH - 1):]


def token_mixer(x, attend, conv_prev, w_in_l, conv_w_l, w_out_l):
    q, k, v, bg, cg, h = project(x, w_in_l)
    a, k_state, v_state = attend(q, k, v)
    c, conv_state = short_conv(cg * h, conv_prev, conv_w_l)
    y = jnp.concatenate([a, bg * c], axis=-1) @ w_out_l
    return y, k_state, v_state, conv_state


def trunk_layer(x, attend, conv_prev, w_in_l, conv_w_l, w_out_l, wg_l, wu_l, wd_l, g_l, b_l):
    x = layer_norm(DN_ALPHA * x + 0.5 * swiglu(x, wg_l[0], wu_l[0], wd_l[0]), g_l[0], b_l[0])
    y, ks, vs, cs = token_mixer(x, attend, conv_prev, w_in_l, conv_w_l, w_out_l)
    x = layer_norm(DN_ALPHA * x + y, g_l[1], b_l[1])
    x = layer_norm(DN_ALPHA * x + 0.5 * swiglu(x, wg_l[1], wu_l[1], wd_l[1]), g_l[2], b_l[2])
    return x, ks, vs, cs


def setup_inputs(seed: int = 0) -> dict:
    key = jax.random.key(seed)
    ks = jax.random.split(key, 16)
    nrm = lambda k, shape: jax.random.normal(k, shape, jnp.float32)
    x_prompt = nrm(ks[0], (BATCH, SEQ, D_MODEL))
    x_sample = nrm(ks[1], (DEC_BATCH, DEC_SEQ, D_MODEL))
    cache_k = nrm(ks[2], (DEPTH, DEC_BATCH, WINDOW, N_KV_HEADS, HEAD_DIM))
    cache_v = nrm(ks[3], (DEPTH, DEC_BATCH, WINDOW, N_KV_HEADS, HEAD_DIM)) * DN_BETA
    state_conv = nrm(ks[4], (DEPTH, DEC_BATCH, CONV_WIDTH - 1, D_CONV)) * DN_BETA
    meta_tokens = nrm(ks[5], (N_META, D_MODEL))
    rel_bias = 0.5 * nrm(ks[6], (N_BUCKETS, N_HEADS))
    col_scale = jnp.concatenate([
        jnp.ones((D_ATTN + D_KV,), jnp.float32),
        jnp.full((D_KV,), DN_BETA, jnp.float32),
        jnp.ones((2 * D_CONV,), jnp.float32),
        jnp.full((D_CONV,), DN_BETA, jnp.float32)])
    w_in = nrm(ks[7], (DEPTH, D_MODEL, D_IN)) * (D_MODEL ** -0.5) * col_scale
    conv_w = nrm(ks[8], (DEPTH, CONV_WIDTH, D_CONV)) * (CONV_WIDTH ** -0.5)
    attn_sink = nrm(ks[9], (DEPTH, N_HEADS))
    w_out = nrm(ks[10], (DEPTH, D_MIX, D_MODEL)) * (D_MIX ** -0.5) * DN_BETA
    ffn_w_gate = nrm(ks[11], (DEPTH, 2, D_MODEL, D_FF)) * (D_MODEL ** -0.5)
    ffn_w_up = nrm(ks[12], (DEPTH, 2, D_MODEL, D_FF)) * (D_MODEL ** -0.5) * DN_BETA
    ffn_w_down = nrm(ks[13], (DEPTH, 2, D_FF, D_MODEL)) * (D_FF ** -0.5) * DN_BETA
    ln_g = 1.0 + 0.02 * nrm(ks[14], (DEPTH, 3, D_MODEL))
    ln_b = 0.02 * nrm(ks[15], (DEPTH, 3, D_MODEL))
    return {"x_prompt": x_prompt, "x_sample": x_sample, "cache_k": cache_k,
            "cache_v": cache_v, "state_conv": state_conv, "meta_tokens": meta_tokens,
            "rel_bias": rel_bias, "w_in": w_in, "conv_w": conv_w, "attn_sink": attn_sink,
            "w_out": w_out, "ffn_w_gate": ffn_w_gate, "ffn_w_up": ffn_w_up,
            "ffn_w_down": ffn_w_down, "ln_g": ln_g, "ln_b": ln_b}


def reference(x_prompt, x_sample, cache_k, cache_v, state_conv, meta_tokens, rel_bias,
              w_in, conv_w, attn_sink, w_out, ffn_w_gate, ffn_w_up, ffn_w_down, ln_g, ln_b):
    Bp = x_prompt.shape[0]
    meta = jnp.broadcast_to(meta_tokens.astype(x_prompt.dtype)[None], (Bp, N_META, D_MODEL))
    xp = jnp.concatenate([meta, x_prompt], axis=1)
    xs = x_sample
    conv_zero = jnp.zeros((Bp, CONV_WIDTH - 1, D_CONV), xp.dtype)

    kp_l, vp_l, cp_l, ks_l, vs_l, cs_l = [], [], [], [], [], []
    for l in range(DEPTH):
        def attend_p(q, k, v, l=l):
            return swa_prompt(q, k, v, attn_sink[l], rel_bias)

        def attend_s(q, k, v, l=l):
            return swa_sample(q, k, v, cache_k[l], cache_v[l], attn_sink[l], rel_bias)

        xp, kp, vp, cp = trunk_layer(xp, attend_p, conv_zero, w_in[l], conv_w[l], w_out[l],
                                     ffn_w_gate[l], ffn_w_up[l], ffn_w_down[l], ln_g[l], ln_b[l])
        xs, kss, vss, css = trunk_layer(xs, attend_s, state_conv[l], w_in[l], conv_w[l], w_out[l],
                                        ffn_w_gate[l], ffn_w_up[l], ffn_w_down[l], ln_g[l], ln_b[l])
        kp_l.append(kp); vp_l.append(vp); cp_l.append(cp)
        ks_l.append(kss); vs_l.append(vss); cs_l.append(css)

    y_prompt = xp[:, N_META:]
    y_sample = xs
    new_k_prompt = jnp.stack(kp_l, axis=0)
    new_v_prompt = jnp.stack(vp_l, axis=0)
    new_conv_prompt = jnp.stack(cp_l, axis=0)
    new_k_sample = jnp.stack(ks_l, axis=0)
    new_v_sample = jnp.stack(vs_l, axis=0)
    new_conv_sample = jnp.stack(cs_l, axis=0)
    return (y_prompt, y_sample, new_k_prompt, new_v_prompt, new_conv_prompt,
            new_k_sample, new_v_sample, new_conv_sample)
```

```cpp
#include <hip/hip_runtime.h>
#include <hip/hip_cooperative_groups.h>
#include <cstdio>
namespace cg = cooperative_groups;

#ifndef MK_MULTI
#define MK_MULTI 0
#endif

#ifndef DISABLE
#define DISABLE 0
#endif
#define DI __device__ __forceinline__
typedef unsigned short bf16_t;
typedef short bf16x8 __attribute__((ext_vector_type(8)));
typedef short s16x4 __attribute__((ext_vector_type(4)));
typedef float f32x16 __attribute__((ext_vector_type(16)));
typedef float f32x4 __attribute__((ext_vector_type(4)));
typedef unsigned u32x4 __attribute__((ext_vector_type(4)));
typedef unsigned u32x2 __attribute__((ext_vector_type(2)));

constexpr int D = 1024, DFF = 2816, DEPTH = 4;
constexpr int LP = 2064, NB = 8, TPR = NB * LP;
constexpr int SB = 128, ST = 4, TSR = SB * ST;
constexpr int T = TPR + TSR;
constexpr int NM = T / 128;
constexpr int NPQ = 1280;
constexpr int DIN = 2304;
constexpr float ALPHA = 1.681792830507429f;
constexpr float LN_EPS = 1e-5f;

struct Params {
  const float* x_prompt; const float* x_sample; const float* cache_k; const float* cache_v; const float* state_conv;
  const float* meta; const float* rel_bias; const float* w_in; const float* conv_w; const float* sink;
  const float* w_out; const float* w_gate; const float* w_up; const float* w_down; const float* ln_g; const float* ln_b;
  float* out;
  bf16_t* Wgu; bf16_t* Wd; bf16_t* Win; bf16_t* Wout;
  float* Xf; bf16_t* Xb; bf16_t* H; bf16_t* P; bf16_t* U; bf16_t* MIX;
  int phase_lo, phase_hi;
};

constexpr size_t O_YP = 0;
constexpr size_t O_YS = O_YP + (size_t)8 * 2048 * 1024;
constexpr size_t O_KP = O_YS + (size_t)512 * 1024;
constexpr size_t O_VP = O_KP + (size_t)4 * 8 * 128 * 128;
constexpr size_t O_CP = O_VP + (size_t)4 * 8 * 128 * 128;
constexpr size_t O_KS = O_CP + (size_t)4 * 8 * 2 * 512;
constexpr size_t O_VS = O_KS + (size_t)4 * 128 * 128 * 128;
constexpr size_t O_CS = O_VS + (size_t)4 * 128 * 128 * 128;

DI unsigned f2bf(float x) { unsigned u = __float_as_uint(x); u += 0x7fffu + ((u >> 16) & 1u); return u >> 16; }
DI unsigned pack2(float lo, float hi) { return f2bf(lo) | (f2bf(hi) << 16); }
DI float bf2f(unsigned short v) { return __uint_as_float(((unsigned)v) << 16); }
DI float bflo(unsigned v) { return __uint_as_float(v << 16); }
DI float bfhi(unsigned v) { return __uint_as_float(v & 0xffff0000u); }

#define MFMA(a, b, c) __builtin_amdgcn_mfma_f32_32x32x16_bf16((a), (b), (c), 0, 0, 0)

DI int lds_off(int row, int chunk) { return row * 128 + ((chunk ^ ((row >> 1) & 7)) << 4); }

template <class Epi>
DI void gemm_tile(const bf16_t* __restrict__ A, int lda, const bf16_t* __restrict__ Bt, int K, int m0, int n0, char* smem, const Epi& epi) {
  const int tid = threadIdx.x, lane = tid & 63, wave = tid >> 6, wm = wave >> 1, wn = wave & 1;
  const int r = lane & 31, h = lane >> 5;
  const int lr = tid >> 3, lc = tid & 7;
  const bf16_t* Ag = A + (size_t)(m0 + lr) * lda + lc * 8;
  const bf16_t* Bg = Bt + (size_t)(n0 + lr) * K + lc * 8;
  u32x4 ra[4], rb[4];
#pragma unroll
  for (int i = 0; i < 4; ++i) { ra[i] = *(const u32x4*)(Ag + (size_t)i * 32 * lda); rb[i] = *(const u32x4*)(Bg + (size_t)i * 32 * K); }
  f32x16 acc[2][2];
#pragma unroll
  for (int a = 0; a < 2; ++a)
#pragma unroll
    for (int b = 0; b < 2; ++b)
#pragma unroll
      for (int i = 0; i < 16; ++i) acc[a][b][i] = 0.f;
#pragma unroll
  for (int i = 0; i < 4; ++i) { *(u32x4*)(smem + lds_off(lr + 32 * i, lc)) = ra[i]; *(u32x4*)(smem + 16384 + lds_off(lr + 32 * i, lc)) = rb[i]; }
  __syncthreads();
  const int nk = K >> 6;
  for (int kt = 0; kt < nk; ++kt) {
    char* sA = smem + (kt & 1) * 32768; char* sB = sA + 16384;
    if (kt + 1 < nk) {
      Ag += 64; Bg += 64;
#pragma unroll
      for (int i = 0; i < 4; ++i) { ra[i] = *(const u32x4*)(Ag + (size_t)i * 32 * lda); rb[i] = *(const u32x4*)(Bg + (size_t)i * 32 * K); }
    }
#pragma unroll
    for (int s = 0; s < 4; ++s) {
      bf16x8 af[2], bfr[2];
#pragma unroll
      for (int t = 0; t < 2; ++t) {
        af[t] = *(const bf16x8*)(sA + lds_off(wm * 64 + t * 32 + r, 2 * s + h));
        bfr[t] = *(const bf16x8*)(sB + lds_off(wn * 64 + t * 32 + r, 2 * s + h));
      }
#pragma unroll
      for (int tm = 0; tm < 2; ++tm)
#pragma unroll
        for (int tn = 0; tn < 2; ++tn) acc[tm][tn] = MFMA(bfr[tn], af[tm], acc[tm][tn]);
    }
    if (kt + 1 < nk) {
      char* dA = smem + ((kt + 1) & 1) * 32768; char* dB = dA + 16384;
#pragma unroll
      for (int i = 0; i < 4; ++i) { *(u32x4*)(dA + lds_off(lr + 32 * i, lc)) = ra[i]; *(u32x4*)(dB + lds_off(lr + 32 * i, lc)) = rb[i]; }
    }
    __syncthreads();
  }
  epi(acc, m0, n0, wm, wn, r, h);
}

template <class Epi>
DI void gemm_phase(const bf16_t* A, int lda, const bf16_t* Bt, int K, int nN, char* smem, const Epi& epi, int vb, int nb) {
  constexpr int CB = 4;
  const int total = NM * nN;
  for (int t = vb; t < total; t += nb) {
    const int cb = t / (NM * CB); const int rem = t - cb * NM * CB; const int width = min(CB, nN - cb * CB);
    const int pm = rem / width; const int pn = cb * CB + rem % width;
    gemm_tile(A, lda, Bt, K, pm * 128, pn * 128, smem, epi);
  }
}

struct EpiGU {
  bf16_t* H;
  DI void operator()(const f32x16 (&acc)[2][2], int m0, int n0, int wm, int wn, int r, int h) const {
    const int cb = ((n0 + wn * 64) >> 1) + 4 * h;
#pragma unroll
    for (int tm = 0; tm < 2; ++tm) {
      const int row = m0 + wm * 64 + tm * 32 + r;
      bf16_t* dst = H + (size_t)row * DFF + cb;
#pragma unroll
      for (int g = 0; g < 4; ++g) {
        float o[4];
#pragma unroll
        for (int j = 0; j < 4; ++j) { const float ga = acc[tm][0][4 * g + j], up = acc[tm][1][4 * g + j]; o[j] = ga * up * __builtin_amdgcn_rcpf(1.f + __expf(-ga)); }
        u32x2 v; v[0] = pack2(o[0], o[1]); v[1] = pack2(o[2], o[3]);
        *(u32x2*)(dst + 8 * g) = v;
      }
    }
  }
};
struct EpiRes {
  float* X; float scale;
  DI void operator()(const f32x16 (&acc)[2][2], int m0, int n0, int wm, int wn, int r, int h) const {
#pragma unroll
    for (int tm = 0; tm < 2; ++tm) {
      const int row = m0 + wm * 64 + tm * 32 + r;
#pragma unroll
      for (int tn = 0; tn < 2; ++tn) {
        float* px = X + (size_t)row * D + n0 + wn * 64 + tn * 32 + 4 * h;
#pragma unroll
        for (int g = 0; g < 4; ++g) {
          f32x4 x = *(const f32x4*)(px + 8 * g);
#pragma unroll
          for (int j = 0; j < 4; ++j) x[j] = ALPHA * x[j] + scale * acc[tm][tn][4 * g + j];
          *(f32x4*)(px + 8 * g) = x;
        }
      }
    }
  }
};
struct EpiIn {
  bf16_t* P; bf16_t* U; float* out; int l;
  DI void operator()(const f32x16 (&acc)[2][2], int m0, int n0, int wm, int wn, int r, int h) const {
#pragma unroll
    for (int tm = 0; tm < 2; ++tm) {
      const int row = m0 + wm * 64 + tm * 32 + r;
      int b, pos; const bool samp = row >= TPR;
      if (!samp) { b = row / LP; pos = row - b * LP; } else { b = (row - TPR) >> 2; pos = (row - TPR) & 3; }
      if (n0 < NPQ) {
        float* so = nullptr;
        if (n0 == 512 || n0 == 640) {
          const size_t vo = (n0 == 640) ? 1 : 0;
          if (!samp) { if (pos >= LP - 128) so = out + O_KP + vo * (O_VP - O_KP) + ((size_t)(l * NB + b) * 128 + (pos - (LP - 128))) * 128; }
          else so = out + O_KS + vo * (O_VS - O_KS) + ((size_t)(l * SB + b) * 128 + 124 + pos) * 128;
        }
#pragma unroll
        for (int tn = 0; tn < 2; ++tn) {
          const int cl = wn * 64 + tn * 32 + 4 * h;
          bf16_t* dst = P + (size_t)row * NPQ + n0 + cl;
#pragma unroll
          for (int g = 0; g < 4; ++g) {
            u32x2 v; v[0] = pack2(acc[tm][tn][4 * g], acc[tm][tn][4 * g + 1]); v[1] = pack2(acc[tm][tn][4 * g + 2], acc[tm][tn][4 * g + 3]);
            *(u32x2*)(dst + 8 * g) = v;
            if (so) { f32x4 f; f[0] = acc[tm][tn][4 * g]; f[1] = acc[tm][tn][4 * g + 1]; f[2] = acc[tm][tn][4 * g + 2]; f[3] = acc[tm][tn][4 * g + 3]; *(f32x4*)(so + cl + 8 * g) = f; }
          }
        }
      } else {
        const int c0 = ((n0 - NPQ + wn * 64) >> 1) + 4 * h;
        float* so = nullptr;
        if (!samp) { if (pos >= LP - 2) so = out + O_CP + ((size_t)(l * NB + b) * 2 + (pos - (LP - 2))) * 512; }
        else if (pos >= 2) so = out + O_CS + ((size_t)(l * SB + b) * 2 + (pos - 2)) * 512;
        bf16_t* dst = U + (size_t)row * 512 + c0;
#pragma unroll
        for (int g = 0; g < 4; ++g) {
          f32x4 f;
#pragma unroll
          for (int j = 0; j < 4; ++j) f[j] = acc[tm][0][4 * g + j] * acc[tm][1][4 * g + j];
          u32x2 v; v[0] = pack2(f[0], f[1]); v[1] = pack2(f[2], f[3]);
          *(u32x2*)(dst + 8 * g) = v;
          if (so) *(f32x4*)(so + c0 + 8 * g) = f;
        }
      }
    }
  }
};

DI void transpose_unit(const float* __restrict__ src, int ld_src, int c0, int k0, bf16_t* __restrict__ dst, int K, int s0, char* smem) {
  bf16_t* t = (bf16_t*)smem;
  const int tid = threadIdx.x, col = tid & 31, kr = tid >> 5;
  float v[16];
#pragma unroll
  for (int i = 0; i < 16; ++i) v[i] = src[(size_t)(k0 + kr + 8 * i) * ld_src + c0 + col];
#pragma unroll
  for (int i = 0; i < 16; ++i) t[col * 136 + kr + 8 * i] = (bf16_t)f2bf(v[i]);
  __syncthreads();
#pragma unroll
  for (int i = 0; i < 2; ++i) {
    const int id = tid + 256 * i, slot = id >> 4, ch = id & 15;
    const u32x4 w = *(const u32x4*)(t + slot * 136 + ch * 8);
    *(u32x4*)(dst + (size_t)(s0 + slot) * K + k0 + ch * 8) = w;
  }
  __syncthreads();
}

DI void prep_phase(const Params& p, char* smem, int bid, int nb) {
  constexpr int U_GU = 176 * 8, U_D = 32 * 22, U_IN = 72 * 8, U_OUT = 32 * 8;
  constexpr int U_L = 2 * U_GU + 2 * U_D + U_IN + U_OUT;
  for (int u = bid; u < DEPTH * U_L; u += nb) {
    const int l = u / U_L; int rem = u - l * U_L;
    if (rem < 2 * U_GU) {
      const int f = rem / U_GU; rem -= f * U_GU; const int sg = rem >> 3, ku = rem & 7;
      const float* src = ((sg & 1) ? p.w_up : p.w_gate) + (size_t)(l * 2 + f) * D * DFF;
      transpose_unit(src, DFF, (sg >> 1) * 32, ku * 128, p.Wgu + (size_t)(l * 2 + f) * 2 * DFF * D, D, sg * 32, smem);
    } else if (rem < 2 * U_GU + 2 * U_D) {
      rem -= 2 * U_GU; const int f = rem / U_D; rem -= f * U_D; const int sg = rem / 22, ku = rem % 22;
      transpose_unit(p.w_down + (size_t)(l * 2 + f) * DFF * D, D, sg * 32, ku * 128, p.Wd + (size_t)(l * 2 + f) * D * DFF, DFF, sg * 32, smem);
    } else if (rem < 2 * U_GU + 2 * U_D + U_IN) {
      rem -= 2 * U_GU + 2 * U_D; const int sg = rem >> 3, ku = rem & 7;
      int c0;
      if (sg < 40) c0 = sg * 32; else { const int g = sg - 40; c0 = ((g & 1) ? 1792 : 1280) + (g >> 1) * 32; }
      transpose_unit(p.w_in + (size_t)l * D * DIN, DIN, c0, ku * 128, p.Win + (size_t)l * DIN * D, D, sg * 32, smem);
    } else {
      rem -= 2 * U_GU + 2 * U_D + U_IN; const int sg = rem >> 3, ku = rem & 7;
      transpose_unit(p.w_out + (size_t)l * D * D, D, sg * 32, ku * 128, p.Wout + (size_t)l * D * D, D, sg * 32, smem);
    }
  }
  const int gt = bid * 256 + threadIdx.x, ngt = nb * 256;
  for (int i = gt; i < T * (D / 4); i += ngt) {
    const int row = i >> 8, c = (i & 255) * 4;
    const float* src;
    if (row < TPR) { const int b = row / LP, pos = row - b * LP; src = pos < 16 ? p.meta + (size_t)pos * D : p.x_prompt + ((size_t)b * 2048 + pos - 16) * D; }
    else src = p.x_sample + (size_t)(row - TPR) * D;
    const f32x4 v = *(const f32x4*)(src + c);
    *(f32x4*)(p.Xf + (size_t)row * D + c) = v;
    u32x2 w; w[0] = pack2(v[0], v[1]); w[1] = pack2(v[2], v[3]);
    *(u32x2*)(p.Xb + (size_t)row * D + c) = w;
  }
  constexpr int PER = 124 * 128 / 4;
  for (int i = gt; i < 2 * DEPTH * SB * PER; i += ngt) {
    const int kv = i / (DEPTH * SB * PER); int rem = i - kv * (DEPTH * SB * PER);
    const int lb = rem / PER; const int e = rem - lb * PER;
    const float* src = (kv ? p.cache_v : p.cache_k) + (size_t)lb * 128 * 128 + 4 * 128 + (size_t)e * 4;
    float* dst = p.out + (kv ? O_VS : O_KS) + (size_t)lb * 128 * 128 + (size_t)e * 4;
    *(f32x4*)dst = *(const f32x4*)src;
  }
}

DI void ln_phase(const Params& p, int lnidx, bool last, int bid, int nb) {
  const int lane = threadIdx.x & 63;
  const int gw = bid * 4 + (threadIdx.x >> 6), nw = nb * 4;
  const float* g = p.ln_g + (size_t)lnidx * D; const float* bb = p.ln_b + (size_t)lnidx * D;
  f32x4 gv[4], bv[4];
#pragma unroll
  for (int i = 0; i < 4; ++i) { gv[i] = *(const f32x4*)(g + i * 256 + lane * 4); bv[i] = *(const f32x4*)(bb + i * 256 + lane * 4); }
  for (int row = gw; row < T; row += nw) {
    float* px = p.Xf + (size_t)row * D;
    f32x4 v[4];
#pragma unroll
    for (int i = 0; i < 4; ++i) v[i] = *(const f32x4*)(px + i * 256 + lane * 4);
    float s = 0.f;
#pragma unroll
    for (int i = 0; i < 4; ++i) s += (v[i][0] + v[i][1]) + (v[i][2] + v[i][3]);
#pragma unroll
    for (int o = 32; o > 0; o >>= 1) s += __shfl_xor(s, o);
    const float mu = s * (1.f / D);
    float q = 0.f;
#pragma unroll
    for (int i = 0; i < 4; ++i)
#pragma unroll
      for (int j = 0; j < 4; ++j) { const float d = v[i][j] - mu; q += d * d; }
#pragma unroll
    for (int o = 32; o > 0; o >>= 1) q += __shfl_xor(q, o);
    const float rstd = 1.0f / sqrtf(q * (1.f / D) + LN_EPS);
    float* po = nullptr;
    if (last) {
      if (row < TPR) { const int b = row / LP, pos = row - b * LP; if (pos >= 16) po = p.out + O_YP + ((size_t)b * 2048 + pos - 16) * D; }
      else po = p.out + O_YS + (size_t)(row - TPR) * D;
    }
#pragma unroll
    for (int i = 0; i < 4; ++i) {
      f32x4 y;
#pragma unroll
      for (int j = 0; j < 4; ++j) y[j] = (v[i][j] - mu) * rstd * gv[i][j] + bv[i][j];
      *(f32x4*)(px + i * 256 + lane * 4) = y;
      u32x2 w; w[0] = pack2(y[0], y[1]); w[1] = pack2(y[2], y[3]);
      *(u32x2*)(p.Xb + (size_t)row * D + i * 256 + lane * 4) = w;
      if (po) *(f32x4*)(po + i * 256 + lane * 4) = y;
    }
  }
}

constexpr int VT_STRIDE = 164;
constexpr int SM_K = 0, SM_VT = 160 * 128, SM_BIAS = SM_VT + 64 * VT_STRIDE * 2;
constexpr int N_ATT_P = NB * 2 * 65, N_ATT_S = SB * 2, N_CONV = T / 32;

DI void attn_item(const Params& p, int l, int item, char* smem) {
  const int tid = threadIdx.x, lane = tid & 63, wave = tid >> 6, r = lane & 31, h = lane >> 5;
  const bool samp = item >= N_ATT_P;
  int b, kvh, q0, seqlen;
  if (!samp) { b = item / 130; const int rem = item - b * 130; kvh = rem / 65; q0 = (rem - kvh * 65) * 32; seqlen = LP; }
  else { const int it = item - N_ATT_P; b = it >> 1; kvh = it & 1; q0 = 128; seqlen = 132; }
  const int rowbase = samp ? (TPR + b * 4 - 128) : b * LP;
  char* sK = smem + SM_K; bf16_t* sVt = (bf16_t*)(smem + SM_VT); const float* sBias = (const float*)(smem + SM_BIAS);
#pragma unroll 1
  for (int idx = tid; idx < 160 * 8; idx += 256) {
    const int j = idx >> 3, c = idx & 7; const int pos = q0 - 128 + j;
    u32x4 kv = {0u, 0u, 0u, 0u}, vv = {0u, 0u, 0u, 0u};
    if (pos >= 0 && pos < seqlen) {
      if (samp && pos < 128) {
        const size_t o = (((size_t)(l * SB + b) * 128 + pos) * 2 + kvh) * 64 + c * 8;
        const f32x4 k0 = *(const f32x4*)(p.cache_k + o), k1 = *(const f32x4*)(p.cache_k + o + 4);
        const f32x4 v0 = *(const f32x4*)(p.cache_v + o), v1 = *(const f32x4*)(p.cache_v + o + 4);
        kv[0] = pack2(k0[0], k0[1]); kv[1] = pack2(k0[2], k0[3]); kv[2] = pack2(k1[0], k1[1]); kv[3] = pack2(k1[2], k1[3]);
        vv[0] = pack2(v0[0], v0[1]); vv[1] = pack2(v0[2], v0[3]); vv[2] = pack2(v1[0], v1[1]); vv[3] = pack2(v1[2], v1[3]);
      } else {
        const bf16_t* src = p.P + (size_t)(rowbase + pos) * NPQ + 512 + kvh * 64 + c * 8;
        kv = *(const u32x4*)src; vv = *(const u32x4*)(src + 128);
      }
    }
    *(u32x4*)(sK + lds_off(j, c)) = kv;
#pragma unroll
    for (int e = 0; e < 4; ++e) {
      sVt[(c * 8 + 2 * e) * VT_STRIDE + j] = (bf16_t)(vv[e] & 0xffffu);
      sVt[(c * 8 + 2 * e + 1) * VT_STRIDE + j] = (bf16_t)(vv[e] >> 16);
    }
  }
  const int head = kvh * 4 + wave;
  const int qpos = min(q0 + r, seqlen - 1);
  const bf16_t* qsrc = p.P + (size_t)(rowbase + qpos) * NPQ + head * 64 + 8 * h;
  bf16x8 qf[4];
#pragma unroll
  for (int s = 0; s < 4; ++s) qf[s] = *(const bf16x8*)(qsrc + 16 * s);
  __syncthreads();
  const float sink = p.sink[l * 8 + head];
  const int jmin = max(0, 128 - q0);
  float m = sink;
  f32x16 acc[5];
#pragma unroll
  for (int kt = 0; kt < 5; ++kt) {
#pragma unroll
    for (int i = 0; i < 16; ++i) acc[kt][i] = 0.f;
#pragma unroll
    for (int s = 0; s < 4; ++s) {
      const bf16x8 kf = *(const bf16x8*)(sK + lds_off(32 * kt + r, 2 * s + h));
      acc[kt] = MFMA(kf, qf[s], acc[kt]);
    }
    const float* bp = sBias + head * 132 + r + 128 - 32 * kt - 4 * h;
#pragma unroll
    for (int i = 0; i < 16; ++i) {
      const int jo = 8 * (i >> 2) + (i & 3);
      const int j = 32 * kt + 4 * h + jo;
      const int d = r + 128 - j;
      const bool valid = (d >= 0) && (d <= 128) && (j >= jmin);
      const float bias = bp[valid ? -jo : (-jo - d)];
      const float sv = valid ? acc[kt][i] * 0.125f + bias : -INFINITY;
      acc[kt][i] = sv; m = fmaxf(m, sv);
    }
    __builtin_amdgcn_sched_barrier(0);
  }
  m = fmaxf(m, __shfl_xor(m, 32));
  float sum = 0.f;
#pragma unroll
  for (int kt = 0; kt < 5; ++kt)
#pragma unroll
    for (int i = 0; i < 16; ++i) { const float e = __expf(acc[kt][i] - m); acc[kt][i] = e; sum += e; }
  sum += __shfl_xor(sum, 32);
  const float inv = 1.f / (sum + __expf(sink - m));
  f32x16 o[2];
#pragma unroll
  for (int dt = 0; dt < 2; ++dt)
#pragma unroll
    for (int i = 0; i < 16; ++i) o[dt][i] = 0.f;
#pragma unroll
  for (int kt = 0; kt < 5; ++kt)
#pragma unroll
    for (int s2 = 0; s2 < 2; ++s2) {
      u32x4 pw;
#pragma unroll
      for (int e = 0; e < 4; ++e) pw[e] = pack2(acc[kt][8 * s2 + 2 * e], acc[kt][8 * s2 + 2 * e + 1]);
      const bf16x8 pf = __builtin_bit_cast(bf16x8, pw);
#pragma unroll
      for (int dt = 0; dt < 2; ++dt) {
        const bf16_t* vp = sVt + (dt * 32 + r) * VT_STRIDE + 32 * kt + 16 * s2 + 4 * h;
        const s16x4 lo = *(const s16x4*)vp, hi = *(const s16x4*)(vp + 8);
        const bf16x8 vf = __builtin_shufflevector(lo, hi, 0, 1, 2, 3, 4, 5, 6, 7);
        o[dt] = MFMA(vf, pf, o[dt]);
      }
      __builtin_amdgcn_sched_barrier(0);
    }
  if (q0 + r < seqlen) {
    bf16_t* dst = p.MIX + (size_t)(rowbase + q0 + r) * D + head * 64 + 4 * h;
#pragma unroll
    for (int dt = 0; dt < 2; ++dt)
#pragma unroll
      for (int g = 0; g < 4; ++g) {
        u32x2 v; v[0] = pack2(o[dt][4 * g] * inv, o[dt][4 * g + 1] * inv); v[1] = pack2(o[dt][4 * g + 2] * inv, o[dt][4 * g + 3] * inv);
        *(u32x2*)(dst + dt * 32 + 8 * g) = v;
      }
  }
  __syncthreads();
}

DI void unpack8(const u32x4 v, float* f) {
#pragma unroll
  for (int e = 0; e < 4; ++e) { f[2 * e] = bflo(v[e]); f[2 * e + 1] = bfhi(v[e]); }
}

DI void conv_item(const Params& p, int l, int item) {
  const int tid = threadIdx.x, c = (tid & 63) * 8, rs = tid >> 6;
  const float* cw = p.conv_w + (size_t)l * 3 * 512 + c;
  float w0[8], w1[8], w2[8];
#pragma unroll
  for (int e = 0; e < 8; ++e) { w0[e] = cw[e]; w1[e] = cw[512 + e]; w2[e] = cw[1024 + e]; }
#pragma unroll 2
  for (int i = 0; i < 8; ++i) {
    const int row = item * 32 + rs + 4 * i;
    float u0[8], u1[8], u2[8], bg[8];
    unpack8(*(const u32x4*)(p.U + (size_t)row * 512 + c), u2);
    unpack8(*(const u32x4*)(p.P + (size_t)row * NPQ + 768 + c), bg);
    if (row < TPR) {
      const int pos = row % LP;
      if (pos >= 1) unpack8(*(const u32x4*)(p.U + (size_t)(row - 1) * 512 + c), u1); else { for (int e = 0; e < 8; ++e) u1[e] = 0.f; }
      if (pos >= 2) unpack8(*(const u32x4*)(p.U + (size_t)(row - 2) * 512 + c), u0); else { for (int e = 0; e < 8; ++e) u0[e] = 0.f; }
    } else {
      const int sb = (row - TPR) >> 2, t = (row - TPR) & 3;
      const float* st = p.state_conv + (size_t)(l * SB + sb) * 2 * 512 + c;
      if (t >= 1) unpack8(*(const u32x4*)(p.U + (size_t)(row - 1) * 512 + c), u1); else { for (int e = 0; e < 8; ++e) u1[e] = st[512 + e]; }
      if (t >= 2) unpack8(*(const u32x4*)(p.U + (size_t)(row - 2) * 512 + c), u0); else { for (int e = 0; e < 8; ++e) u0[e] = st[t * 512 + e]; }
    }
    u32x4 ov;
#pragma unroll
    for (int e = 0; e < 4; ++e) {
      const float a = bg[2 * e] * (w0[2 * e] * u0[2 * e] + w1[2 * e] * u1[2 * e] + w2[2 * e] * u2[2 * e]);
      const float bq = bg[2 * e + 1] * (w0[2 * e + 1] * u0[2 * e + 1] + w1[2 * e + 1] * u1[2 * e + 1] + w2[2 * e + 1] * u2[2 * e + 1]);
      ov[e] = pack2(a, bq);
    }
    *(u32x4*)(p.MIX + (size_t)row * D + 512 + c) = ov;
  }
}

DI void mix_phase(const Params& p, int l, char* smem, int bid, int nb) {
  float* sBias = (float*)(smem + SM_BIAS);
  for (int i = threadIdx.x; i < 8 * 129; i += 256) {
    const int hd = i / 129, d = i - hd * 129;
    int bk;
    if (d < 16) bk = d; else { bk = 16 + (int)(log2f((float)d * (1.f / 16.f)) * (16.f / 3.f) + 1e-4f); bk = min(bk, 31); }
    sBias[hd * 132 + d] = p.rel_bias[bk * 8 + hd];
  }
  __syncthreads();
  const int total = N_ATT_P + N_ATT_S + N_CONV;
  for (int it = bid; it < total; it += nb) {
    if (it < N_ATT_P + N_ATT_S) attn_item(p, l, it, smem);
    else conv_item(p, l, it - (N_ATT_P + N_ATT_S));
  }
}

__global__ void __launch_bounds__(256, 2) mk_forward(Params p) {
  __shared__ __attribute__((aligned(16))) char smem[65536];
  const int nb = gridDim.x, bid = blockIdx.x;
  const int vb = (nb & 7) ? bid : (bid & 7) * (nb >> 3) + (bid >> 3);
  for (int ph = p.phase_lo; ph < p.phase_hi; ++ph) {
    if (ph == 0) { if (!(DISABLE & 1)) prep_phase(p, smem, bid, nb); }
    else {
      const int l = (ph - 1) / 10, s = (ph - 1) % 10;
      switch (s) {
        case 0: case 7: if (!(DISABLE & 2)) {
          const int f = s == 0 ? 0 : 1;
          EpiGU e{p.H};
          gemm_phase(p.Xb, D, p.Wgu + (size_t)(l * 2 + f) * 2 * DFF * D, D, 44, smem, e, vb, nb);
        } break;
        case 1: case 8: if (!(DISABLE & 4)) {
          const int f = s == 1 ? 0 : 1;
          EpiRes e{p.Xf, 0.5f};
          gemm_phase(p.H, DFF, p.Wd + (size_t)(l * 2 + f) * D * DFF, DFF, 8, smem, e, vb, nb);
        } break;
        case 2: if (!(DISABLE & 8)) ln_phase(p, l * 3 + 0, false, bid, nb); break;
        case 6: if (!(DISABLE & 8)) ln_phase(p, l * 3 + 1, false, bid, nb); break;
        case 9: if (!(DISABLE & 8)) ln_phase(p, l * 3 + 2, l == DEPTH - 1, bid, nb); break;
        case 3: if (!(DISABLE & 16)) {
          EpiIn e{p.P, p.U, p.out, l};
          gemm_phase(p.Xb, D, p.Win + (size_t)l * DIN * D, D, 18, smem, e, vb, nb);
        } break;
        case 4: if (!(DISABLE & 32)) mix_phase(p, l, smem, bid, nb); break;
        case 5: if (!(DISABLE & 64)) {
          EpiRes e{p.Xf, 1.0f};
          gemm_phase(p.MIX, D, p.Wout + (size_t)l * D * D, D, 8, smem, e, vb, nb);
        } break;
      }
    }
    if (ph + 1 < p.phase_hi) cg::this_grid().sync();
  }
}

extern "C" void kernel_launch(void* const* d_in, const int* in_sizes, int n_in, void* d_out, int out_size, void* d_ws, size_t ws_size, hipStream_t stream) {
  static int grid_blocks = 0;
  if (!grid_blocks) {
    int dev = 0, cus = 0, per_cu = 0;
    hipGetDevice(&dev);
    hipDeviceGetAttribute(&cus, hipDeviceAttributeMultiprocessorCount, dev);
    hipOccupancyMaxActiveBlocksPerMultiprocessor(&per_cu, mk_forward, 256, 0);
    if (per_cu > 2) per_cu = 2;
    if (per_cu < 1) per_cu = 1;
    grid_blocks = cus * per_cu;
  }
  Params p{};
  p.x_prompt = (const float*)d_in[0]; p.x_sample = (const float*)d_in[1]; p.cache_k = (const float*)d_in[2]; p.cache_v = (const float*)d_in[3];
  p.state_conv = (const float*)d_in[4]; p.meta = (const float*)d_in[5]; p.rel_bias = (const float*)d_in[6]; p.w_in = (const float*)d_in[7];
  p.conv_w = (const float*)d_in[8]; p.sink = (const float*)d_in[9]; p.w_out = (const float*)d_in[10]; p.w_gate = (const float*)d_in[11];
  p.w_up = (const float*)d_in[12]; p.w_down = (const float*)d_in[13]; p.ln_g = (const float*)d_in[14]; p.ln_b = (const float*)d_in[15];
  p.out = (float*)d_out;
  char* w = (char*)d_ws; size_t off = 0;
  auto take = [&](size_t bytes) { char* q = w + off; off += (bytes + 255) & ~(size_t)255; return q; };
  p.Wgu = (bf16_t*)take((size_t)DEPTH * 2 * 2 * DFF * D * 2);
  p.Wd = (bf16_t*)take((size_t)DEPTH * 2 * D * DFF * 2);
  p.Win = (bf16_t*)take((size_t)DEPTH * DIN * D * 2);
  p.Wout = (bf16_t*)take((size_t)DEPTH * D * D * 2);
  p.Xf = (float*)take((size_t)T * D * 4);
  p.Xb = (bf16_t*)take((size_t)T * D * 2);
  p.H = (bf16_t*)take((size_t)T * DFF * 2);
  p.P = p.H; p.U = p.P + (size_t)T * NPQ; p.MIX = p.U + (size_t)T * 512;
  const int NPH = 1 + 10 * DEPTH;
#if MK_MULTI
  for (int ph = 0; ph < NPH; ++ph) {
    p.phase_lo = ph; p.phase_hi = ph + 1;
    hipLaunchKernelGGL(mk_forward, dim3(grid_blocks), dim3(256), 0, stream, p);
  }
#else
  p.phase_lo = 0; p.phase_hi = NPH;
  void* args[] = {&p};
  hipError_t e = hipLaunchCooperativeKernel((void*)mk_forward, dim3(grid_blocks), dim3(256), args, 0, stream);
  if (e != hipSuccess) fprintf(stderr, "cooperative launch failed: %s (grid %d)\n", hipGetErrorString(e), grid_blocks);
#endif
}
```

```cpp
#include <hip/hip_runtime.h>
#include <hip/hip_cooperative_groups.h>
#include <cstdio>
namespace cg = cooperative_groups;

#ifndef MK_MULTI
#define MK_MULTI 0
#endif
#ifndef DISABLE
#define DISABLE 0
#endif
#define DI __device__ __forceinline__
namespace pg8 {
#define PG8_LAS __attribute__((address_space(3)))
typedef unsigned short bf16_t;
typedef short bf16x8 __attribute__((ext_vector_type(8)));
typedef float f32x4 __attribute__((ext_vector_type(4)));
typedef unsigned u32x4 __attribute__((ext_vector_type(4)));
constexpr int BM = 256, BK = 64, HALF = 128, HTB = HALF * BK * 2  , STAGE_BYTES = 8 * HTB, NXCD = 8, WGM = 8;

__host__ __device__ __forceinline__ int lds_byte(int r, int c) { const int st = (r >> 4) * 2 + (c >> 5), rr = r & 15, cc = c & 31, ob = rr * 64 + cc * 2; return st * 1024 + (ob ^ (((ob >> 9) & 1) << 5)); }
__host__ __device__ __forceinline__ void stage_rc(int b, int& R, int& C) { const int st = b / 1024, sb = b % 1024, swz = sb ^ (((sb >> 9) & 1) << 5); R = (st >> 1) * 16 + swz / 64; C = (st & 1) * 32 + (swz % 64) / 2; }
__host__ __device__ __forceinline__ int perm32(int rho) { const int n = rho >> 4, i = rho & 15; return 8 * (i >> 2) + 4 * n + (i & 3); }

struct Unit { int pm, pn; };
struct Gemm { const bf16_t* A; const bf16_t* Bt; int M, N, K; };

struct StaticOrder {
    int nM, nN, nwg, G, c;
    __host__ __device__ void init(int M, int N, int G_, int c_) { nM = M / BM; nN = N / BM; nwg = nM * nN; G = G_; c = c_; }
    __host__ __device__ bool next(int i, Unit& u) const {
        const long L = (long)i * G + c; if (L >= nwg) return false;
        int wgid = (int)L; { const int q = nwg / NXCD, r = nwg % NXCD, xcd = wgid % NXCD, off = wgid / NXCD; wgid = (xcd < r ? xcd * (q + 1) : r * (q + 1) + (xcd - r) * q) + off; }
        const int nig = WGM * nN, gid = wgid / nig, fm = gid * WGM, gsz = (nM - fm) < WGM ? (nM - fm) : WGM;
        u.pm = fm + ((wgid % nig) % gsz); u.pn = (wgid % nig) / gsz; return true;
    }
    __device__ __forceinline__ void a_ready(const Unit&) const {}
    __device__ __forceinline__ void done(const Unit&) const {}
};

template <class Epi, class Sched, bool STAMP = false>
__device__ __forceinline__ void gemm_phase(PG8_LAS unsigned char* lds, const Gemm g, const Sched& S, const Epi& E, unsigned long long* stamps, const int tid) {
    const int wid = __builtin_amdgcn_readfirstlane(tid >> 6), lane = tid & 63, wr = wid >> 2, wc = wid & 3, fr = lane & 15, fq = lane >> 4;
    const int K = g.K, nt = K / BK;
    int ts_lo = 0, ts_hi = 0, nts = 0; const unsigned long long rt_entry = STAMP ? (unsigned long long)wall_clock64() : 0ull;
#define PG8_STAMP() do { if (STAMP && wid == 0 && nts < 64) { const unsigned long long _c = (unsigned long long)clock64(); \
        ts_lo = (lane == nts) ? (int)(unsigned)_c : ts_lo; ts_hi = (lane == nts) ? (int)(unsigned)(_c >> 32) : ts_hi; ++nts; } } while (0)
    PG8_STAMP();
    unsigned voffA[2], voffB[2];
#pragma unroll
    for (int i = 0; i < 2; ++i) { int R, C; stage_rc(tid * 16 + i * 8192, R, C); const int Rb = Epi::PERM ? ((R & ~31) + perm32(R & 31)) : R;
        voffA[i] = (unsigned)(R * K + C) * 2u; voffB[i] = (unsigned)(Rb * K + C) * 2u; }
    const size_t kstep = (size_t)(BK * 2);
    const size_t hstep = (size_t)HALF * K * 2;
    const size_t tstep = 2 * hstep;
    const unsigned ldsw = (unsigned)wid * 1024u;
    const int aoff = lds_byte(wr * 64 + fr, fq * 8), boff = lds_byte(wc * 32 + fr, fq * 8);
#define PG8_SA(b, h) (((b) * 2 + (h)) * HTB)
#define PG8_SB(b, h) ((4 + (b) * 2 + (h)) * HTB)
#define PG8_STAGE(bufoff, gbase, voff) do { _Pragma("unroll") for (int _i = 0; _i < 2; ++_i) \
        __builtin_amdgcn_global_load_lds((const unsigned*)((const char*)(gbase) + (voff)[_i]), (PG8_LAS unsigned*)(lds + (bufoff) + ldsw + _i * 8192), 16, 0, 0); } while (0)
#define PG8_LDA(dst, b, h) do { _Pragma("unroll") for (int m = 0; m < 4; ++m) _Pragma("unroll") for (int k = 0; k < 2; ++k) dst[m][k] = *(const PG8_LAS bf16x8*)(lds + PG8_SA(b, h) + aoff + m * 2048 + k * 1024); } while (0)
#define PG8_LDB(dst, b, h) do { _Pragma("unroll") for (int n = 0; n < 2; ++n) _Pragma("unroll") for (int k = 0; k < 2; ++k) dst[n][k] = *(const PG8_LAS bf16x8*)(lds + PG8_SB(b, h) + boff + n * 2048 + k * 1024); } while (0)
#define PG8_MMA(ai, bj, At, Bt) do { __builtin_amdgcn_s_setprio(1); _Pragma("unroll") for (int m = 0; m < 4; ++m) _Pragma("unroll") for (int n = 0; n < 2; ++n) _Pragma("unroll") for (int k = 0; k < 2; ++k) \
        acc[ai][bj][m][n] = __builtin_amdgcn_mfma_f32_16x16x32_bf16(Bt[n][k], At[m][k], acc[ai][bj][m][n], 0, 0, 0); __builtin_amdgcn_s_setprio(0); } while (0)
#define PG8_WAIT_V(n) asm volatile("s_waitcnt vmcnt(" #n ")" ::: "memory")
#define PG8_WAIT_L(n) asm volatile("s_waitcnt lgkmcnt(" #n ")" ::: "memory")
#define PG8_BAR __builtin_amdgcn_s_barrier()
#define PG8_SCHED __builtin_amdgcn_sched_barrier(0)
    Unit cur, nxt; int ui = 0;
    if (!S.next(0, cur)) return;
    f32x4 acc[2][2][4][2];
#pragma unroll
    for (int a = 0; a < 2; ++a)
#pragma unroll
        for (int b = 0; b < 2; ++b)
#pragma unroll
            for (int m = 0; m < 4; ++m)
#pragma unroll
                for (int n = 0; n < 2; ++n) acc[a][b][m][n] = (f32x4){0.f, 0.f, 0.f, 0.f};
    bf16x8 At[4][2], B0[2][2], B1[2][2];
    const char* cA = (const char*)g.A + (size_t)cur.pm * tstep; const char* cB = (const char*)g.Bt + (size_t)cur.pn * tstep;
    S.a_ready(cur);
    PG8_STAGE(PG8_SB(0, 0), cB, voffB); PG8_STAGE(PG8_SA(0, 0), cA, voffA); PG8_STAGE(PG8_SB(0, 1), cB + hstep, voffB); PG8_STAGE(PG8_SA(0, 1), cA + hstep, voffA);
    if (wr == 1) PG8_BAR;
    PG8_WAIT_V(4); PG8_BAR;
    PG8_STAGE(PG8_SB(1, 0), cB + kstep, voffB); PG8_STAGE(PG8_SA(1, 0), cA + kstep, voffA); PG8_STAGE(PG8_SB(1, 1), cB + hstep + kstep, voffB);
    PG8_WAIT_V(6); PG8_BAR;
    PG8_STAMP();
    for (;;) {
        const bool has_next = S.next(ui + 1, nxt);
        const char* nA = has_next ? (const char*)g.A + (size_t)nxt.pm * tstep : cA; const char* nB = has_next ? (const char*)g.Bt + (size_t)nxt.pn * tstep : cB;
        for (int t = 0; t < nt; t += 2) {
            const bool last = (t == nt - 2);
            const char* a1 = cA + (size_t)(t + 1) * kstep;
            const char* a2 = last ? nA : cA + (size_t)(t + 2) * kstep; const char* b2 = last ? nB : cB + (size_t)(t + 2) * kstep;
            const char* a3 = a2 + kstep; const char* b3 = b2 + kstep;
            if (last && has_next) S.a_ready(nxt);
            PG8_LDB(B0, 0, 0); PG8_SCHED; PG8_LDA(At, 0, 0); PG8_STAGE(PG8_SA(1, 1), a1 + hstep, voffA);
            PG8_WAIT_L(8); PG8_BAR; PG8_WAIT_L(0); PG8_MMA(0, 0, At, B0); PG8_BAR; PG8_SCHED;
            PG8_LDB(B1, 0, 1); PG8_STAGE(PG8_SB(0, 0), b2, voffB);
            PG8_BAR; PG8_WAIT_L(0); PG8_MMA(0, 1, At, B1); PG8_BAR;
            PG8_LDA(At, 0, 1); PG8_STAGE(PG8_SA(0, 0), a2, voffA);
            PG8_BAR; PG8_WAIT_L(0); PG8_MMA(1, 0, At, B0); PG8_BAR; PG8_SCHED;
            PG8_STAGE(PG8_SB(0, 1), b2 + hstep, voffB);
            PG8_WAIT_V(6); PG8_BAR; PG8_MMA(1, 1, At, B1); PG8_BAR;
            PG8_LDB(B0, 1, 0); PG8_SCHED; PG8_LDA(At, 1, 0); PG8_STAGE(PG8_SA(0, 1), a2 + hstep, voffA);
            PG8_WAIT_L(8); PG8_BAR; PG8_WAIT_L(0); PG8_MMA(0, 0, At, B0); PG8_BAR; PG8_SCHED;
            PG8_LDB(B1, 1, 1); PG8_STAGE(PG8_SB(1, 0), b3, voffB);
            PG8_BAR; PG8_WAIT_L(0); PG8_MMA(0, 1, At, B1); PG8_BAR;
            PG8_LDA(At, 1, 1); PG8_STAGE(PG8_SA(1, 0), a3, voffA);
            PG8_BAR; PG8_WAIT_L(0); PG8_MMA(1, 0, At, B0); PG8_BAR; PG8_SCHED;
            PG8_STAGE(PG8_SB(1, 1), b3 + hstep, voffB);
            PG8_WAIT_V(6); PG8_BAR; PG8_MMA(1, 1, At, B1); PG8_BAR;
        }
        PG8_STAMP();
        if constexpr (!Epi::AFTER_DRAIN) { E(acc, cur, wr, wc, fr, fq); S.done(cur); }
        PG8_STAMP();
        if (!has_next) break;
#pragma unroll
        for (int a = 0; a < 2; ++a)
#pragma unroll
            for (int b = 0; b < 2; ++b)
#pragma unroll
                for (int m = 0; m < 4; ++m)
#pragma unroll
                    for (int n = 0; n < 2; ++n) acc[a][b][m][n] = (f32x4){0.f, 0.f, 0.f, 0.f};
        cur = nxt; cA = nA; cB = nB; ++ui;
    }
    PG8_WAIT_V(0);
    if (wr == 0) PG8_BAR;
    PG8_BAR;
    if constexpr (Epi::AFTER_DRAIN) { E.fused(acc, cur, wr, wc, fr, fq, lds, wid, lane); S.done(cur); }
    PG8_STAMP();
    if (STAMP && wid == 0) { stamps[lane] = lane < nts ? (((unsigned long long)(unsigned)ts_hi << 32) | (unsigned)ts_lo) : 0ull;
        if (lane == 62) stamps[62] = rt_entry; if (lane == 63) stamps[63] = (unsigned long long)wall_clock64(); }
#undef PG8_STAMP
#undef PG8_SA
#undef PG8_SB
#undef PG8_STAGE
#undef PG8_LDA
#undef PG8_LDB
#undef PG8_MMA
#undef PG8_WAIT_V
#undef PG8_WAIT_L
#undef PG8_BAR
#undef PG8_SCHED
}
}


using pg8::bf16_t; using pg8::bf16x8; using pg8::f32x4; using pg8::u32x4;
typedef short s16x4 __attribute__((ext_vector_type(4)));
typedef float f32x16 __attribute__((ext_vector_type(16)));
typedef unsigned u32x2 __attribute__((ext_vector_type(2)));

constexpr int D = 1024, DFF = 2816, DEPTH = 4;
constexpr int LP = 2064, NB = 8, TPR = NB * LP;
constexpr int SB = 128, ST = 4, TSR = SB * ST;
constexpr int T = TPR + TSR;
constexpr int TPAD = 17152;
constexpr int NPQ = 1280;
constexpr int DIN = 2304;
constexpr float ALPHA = 1.681792830507429f;
constexpr float LN_EPS = 1e-5f;
constexpr int LDS_BYTES = 131072;
constexpr int NT = 512;

struct Params {
  const float* x_prompt; const float* x_sample; const float* cache_k; const float* cache_v; const float* state_conv;
  const float* meta; const float* rel_bias; const float* w_in; const float* conv_w; const float* sink;
  const float* w_out; const float* w_gate; const float* w_up; const float* w_down; const float* ln_g; const float* ln_b;
  float* out;
  bf16_t* Wgu; bf16_t* Wd; bf16_t* Win; bf16_t* Wout;
  float* Xf; bf16_t* Xb; bf16_t* H; bf16_t* P; bf16_t* U; bf16_t* MIX;
  int phase_lo, phase_hi;
};

constexpr size_t O_YP = 0;
constexpr size_t O_YS = O_YP + (size_t)8 * 2048 * 1024;
constexpr size_t O_KP = O_YS + (size_t)512 * 1024;
constexpr size_t O_VP = O_KP + (size_t)4 * 8 * 128 * 128;
constexpr size_t O_CP = O_VP + (size_t)4 * 8 * 128 * 128;
constexpr size_t O_KS = O_CP + (size_t)4 * 8 * 2 * 512;
constexpr size_t O_VS = O_KS + (size_t)4 * 128 * 128 * 128;
constexpr size_t O_CS = O_VS + (size_t)4 * 128 * 128 * 128;

DI unsigned f2bf(float x) { unsigned u = __float_as_uint(x); u += 0x7fffu + ((u >> 16) & 1u); return u >> 16; }
DI unsigned pack2(float lo, float hi) { return f2bf(lo) | (f2bf(hi) << 16); }
DI float bflo(unsigned v) { return __uint_as_float(v << 16); }
DI float bfhi(unsigned v) { return __uint_as_float(v & 0xffff0000u); }

#define MFMA32(a, b, c) __builtin_amdgcn_mfma_f32_32x32x16_bf16((a), (b), (c), 0, 0, 0)

DI int lds_off(int row, int chunk) { return row * 128 + ((chunk ^ ((row >> 1) & 7)) << 4); }

struct EpiGU {
  static constexpr bool PERM = true, AFTER_DRAIN = false;
  bf16_t* H;
  DI void operator()(const f32x4 (&acc)[2][2][4][2], const pg8::Unit& u, int wr, int wc, int fr, int fq) const {
    const int row0 = u.pm * 256 + wr * 64 + fr, col0 = u.pn * 128 + wc * 32 + 8 * fq;
#pragma unroll
    for (int ai = 0; ai < 2; ++ai)
#pragma unroll
      for (int m = 0; m < 4; ++m) {
        const int row = row0 + ai * 128 + m * 16;
        if (row < T) {
          float o[8];
#pragma unroll
          for (int n = 0; n < 2; ++n)
#pragma unroll
            for (int j = 0; j < 4; ++j) { const float ga = acc[ai][0][m][n][j], up = acc[ai][1][m][n][j]; o[4 * n + j] = ga * up * __builtin_amdgcn_rcpf(1.f + __expf(-ga)); }
          u32x4 w; w[0] = pack2(o[0], o[1]); w[1] = pack2(o[2], o[3]); w[2] = pack2(o[4], o[5]); w[3] = pack2(o[6], o[7]);
          *(u32x4*)(H + (size_t)row * DFF + col0) = w;
        }
      }
  }
};
struct EpiRes {
  static constexpr bool PERM = false, AFTER_DRAIN = false;
  float* X; float scale;
  DI void operator()(const f32x4 (&acc)[2][2][4][2], const pg8::Unit& u, int wr, int wc, int fr, int fq) const {
    const int row0 = u.pm * 256 + wr * 64 + fr, col0 = u.pn * 256 + wc * 32 + 4 * fq;
#pragma unroll
    for (int ai = 0; ai < 2; ++ai)
#pragma unroll
      for (int m = 0; m < 4; ++m) {
        const int row = row0 + ai * 128 + m * 16;
        if (row < T) {
          float* px = X + (size_t)row * D + col0;
#pragma unroll
          for (int bj = 0; bj < 2; ++bj)
#pragma unroll
            for (int n = 0; n < 2; ++n) {
              f32x4 x = *(const f32x4*)(px + bj * 128 + n * 16);
#pragma unroll
              for (int j = 0; j < 4; ++j) x[j] = ALPHA * x[j] + scale * acc[ai][bj][m][n][j];
              *(f32x4*)(px + bj * 128 + n * 16) = x;
            }
        }
      }
  }
};
struct EpiIn {
  static constexpr bool PERM = true, AFTER_DRAIN = false;
  bf16_t* P; bf16_t* U; float* out; int l;
  DI void operator()(const f32x4 (&acc)[2][2][4][2], const pg8::Unit& u, int wr, int wc, int fr, int fq) const {
    const int row0 = u.pm * 256 + wr * 64 + fr, cl = wc * 32 + 8 * fq;
#pragma unroll
    for (int ai = 0; ai < 2; ++ai)
#pragma unroll
      for (int m = 0; m < 4; ++m) {
        const int row = row0 + ai * 128 + m * 16;
        if (row >= T) continue;
        int b, pos; const bool samp = row >= TPR;
        if (!samp) { b = row / LP; pos = row - b * LP; } else { b = (row - TPR) >> 2; pos = (row - TPR) & 3; }
        if (u.pn < 5) {
#pragma unroll
          for (int bj = 0; bj < 2; ++bj) {
            const f32x4 v0 = acc[ai][bj][m][0], v1 = acc[ai][bj][m][1];
            u32x4 w; w[0] = pack2(v0[0], v0[1]); w[1] = pack2(v0[2], v0[3]); w[2] = pack2(v1[0], v1[1]); w[3] = pack2(v1[2], v1[3]);
            *(u32x4*)(P + (size_t)row * NPQ + u.pn * 256 + bj * 128 + cl) = w;
            if (u.pn == 2) {
              float* so = nullptr;
              if (!samp) { if (pos >= LP - 128) so = out + (bj ? O_VP : O_KP) + ((size_t)(l * NB + b) * 128 + (pos - (LP - 128))) * 128; }
              else so = out + (bj ? O_VS : O_KS) + ((size_t)(l * SB + b) * 128 + 124 + pos) * 128;
              if (so) { *(f32x4*)(so + cl) = v0; *(f32x4*)(so + cl + 4) = v1; }
            }
          }
        } else {
          f32x4 f0, f1;
#pragma unroll
          for (int j = 0; j < 4; ++j) { f0[j] = acc[ai][0][m][0][j] * acc[ai][1][m][0][j]; f1[j] = acc[ai][0][m][1][j] * acc[ai][1][m][1][j]; }
          const int c0 = (u.pn - 5) * 128 + cl;
          u32x4 w; w[0] = pack2(f0[0], f0[1]); w[1] = pack2(f0[2], f0[3]); w[2] = pack2(f1[0], f1[1]); w[3] = pack2(f1[2], f1[3]);
          *(u32x4*)(U + (size_t)row * 512 + c0) = w;
          float* so = nullptr;
          if (!samp) { if (pos >= LP - 2) so = out + O_CP + ((size_t)(l * NB + b) * 2 + (pos - (LP - 2))) * 512; }
          else if (pos >= 2) so = out + O_CS + ((size_t)(l * SB + b) * 2 + (pos - 2)) * 512;
          if (so) { *(f32x4*)(so + c0) = f0; *(f32x4*)(so + c0 + 4) = f1; }
        }
      }
  }
};

template <class Epi>
DI void run_gemm(unsigned char* lds, const bf16_t* A, const bf16_t* Bt, int N, int K, const Epi& e, const int tid) {
  pg8::Gemm g; g.A = A; g.Bt = Bt; g.M = TPAD; g.N = N; g.K = K;
  pg8::StaticOrder S; S.init(TPAD, N, (int)gridDim.x, (int)blockIdx.x);
  pg8::gemm_phase<Epi, pg8::StaticOrder, false>((PG8_LAS unsigned char*)lds, g, S, e, nullptr, tid);
}

DI void transpose_unit(const float* __restrict__ src, int ld_src, int c0, int k0, bf16_t* __restrict__ dst, int K, int s0, const int tid) {
  const int lane = tid & 63, wave = tid >> 6;
  const float* s = src + (size_t)(k0 + 32 * wave) * ld_src + c0 + lane;
  bf16_t* d = dst + (size_t)(s0 + lane) * K + k0 + 32 * wave;
  float v[32];
#pragma unroll
  for (int e = 0; e < 32; ++e) v[e] = s[(size_t)e * ld_src];
#pragma unroll
  for (int g = 0; g < 4; ++g) {
    u32x4 w; w[0] = pack2(v[8 * g], v[8 * g + 1]); w[1] = pack2(v[8 * g + 2], v[8 * g + 3]); w[2] = pack2(v[8 * g + 4], v[8 * g + 5]); w[3] = pack2(v[8 * g + 6], v[8 * g + 7]);
    *(u32x4*)(d + 8 * g) = w;
  }
}

DI void prep_phase(const Params& p, int bid, int nb, const int tid) {
  constexpr int U_GU = 88 * 4, U_D = 16 * 11, U_IN = 36 * 4, U_OUT = 16 * 4;
  constexpr int U_L = 2 * U_GU + 2 * U_D + U_IN + U_OUT;
  for (int u = bid; u < DEPTH * U_L; u += nb) {
    const int l = u / U_L; int rem = u - l * U_L;
    if (rem < 2 * U_GU) {
      const int f = rem / U_GU; rem -= f * U_GU; const int sg = rem >> 2, ku = rem & 3;
      const int tile = sg >> 2, q = sg & 3;
      const float* src = ((q >> 1) ? p.w_up : p.w_gate) + (size_t)(l * 2 + f) * D * DFF;
      transpose_unit(src, DFF, tile * 128 + (q & 1) * 64, ku * 256, p.Wgu + (size_t)(l * 2 + f) * 2 * DFF * D, D, sg * 64, tid);
    } else if (rem < 2 * U_GU + 2 * U_D) {
      rem -= 2 * U_GU; const int f = rem / U_D; rem -= f * U_D; const int sg = rem / 11, ku = rem % 11;
      transpose_unit(p.w_down + (size_t)(l * 2 + f) * DFF * D, D, sg * 64, ku * 256, p.Wd + (size_t)(l * 2 + f) * D * DFF, DFF, sg * 64, tid);
    } else if (rem < 2 * U_GU + 2 * U_D + U_IN) {
      rem -= 2 * U_GU + 2 * U_D; const int sg = rem >> 2, ku = rem & 3;
      int c0;
      if (sg < 20) c0 = sg * 64; else { const int g = sg - 20, i = g >> 2, q = g & 3; c0 = ((q >> 1) ? 1792 : 1280) + 128 * i + (q & 1) * 64; }
      transpose_unit(p.w_in + (size_t)l * D * DIN, DIN, c0, ku * 256, p.Win + (size_t)l * DIN * D, D, sg * 64, tid);
    } else {
      rem -= 2 * U_GU + 2 * U_D + U_IN; const int sg = rem >> 2, ku = rem & 3;
      transpose_unit(p.w_out + (size_t)l * D * D, D, sg * 64, ku * 256, p.Wout + (size_t)l * D * D, D, sg * 64, tid);
    }
  }
  const int gt = bid * NT + tid, ngt = nb * NT;
  for (int i = gt; i < T * (D / 4); i += ngt) {
    const int row = i >> 8, c = (i & 255) * 4;
    const float* src;
    if (row < TPR) { const int b = row / LP, pos = row - b * LP; src = pos < 16 ? p.meta + (size_t)pos * D : p.x_prompt + ((size_t)b * 2048 + pos - 16) * D; }
    else src = p.x_sample + (size_t)(row - TPR) * D;
    const f32x4 v = *(const f32x4*)(src + c);
    *(f32x4*)(p.Xf + (size_t)row * D + c) = v;
    u32x2 w; w[0] = pack2(v[0], v[1]); w[1] = pack2(v[2], v[3]);
    *(u32x2*)(p.Xb + (size_t)row * D + c) = w;
  }
  constexpr int PER = 124 * 128 / 4;
  for (int i = gt; i < 2 * DEPTH * SB * PER; i += ngt) {
    const int kv = i / (DEPTH * SB * PER); int rem = i - kv * (DEPTH * SB * PER);
    const int lb = rem / PER; const int e = rem - lb * PER;
    const float* src = (kv ? p.cache_v : p.cache_k) + (size_t)lb * 128 * 128 + 4 * 128 + (size_t)e * 4;
    float* dst = p.out + (kv ? O_VS : O_KS) + (size_t)lb * 128 * 128 + (size_t)e * 4;
    *(f32x4*)dst = *(const f32x4*)src;
  }
}

DI void ln_phase(const Params& p, int lnidx, bool last, int bid, int nb, const int tid) {
  const int lane = tid & 63;
  const int gw = bid * (NT / 64) + (tid >> 6), nw = nb * (NT / 64);
  const float* g = p.ln_g + (size_t)lnidx * D; const float* bb = p.ln_b + (size_t)lnidx * D;
  f32x4 gv[4], bv[4];
#pragma unroll
  for (int i = 0; i < 4; ++i) { gv[i] = *(const f32x4*)(g + i * 256 + lane * 4); bv[i] = *(const f32x4*)(bb + i * 256 + lane * 4); }
  for (int row = gw; row < T; row += nw) {
    float* px = p.Xf + (size_t)row * D;
    f32x4 v[4];
#pragma unroll
    for (int i = 0; i < 4; ++i) v[i] = *(const f32x4*)(px + i * 256 + lane * 4);
    float s = 0.f;
#pragma unroll
    for (int i = 0; i < 4; ++i) s += (v[i][0] + v[i][1]) + (v[i][2] + v[i][3]);
#pragma unroll
    for (int o = 32; o > 0; o >>= 1) s += __shfl_xor(s, o);
    const float mu = s * (1.f / D);
    float q = 0.f;
#pragma unroll
    for (int i = 0; i < 4; ++i)
#pragma unroll
      for (int j = 0; j < 4; ++j) { const float d = v[i][j] - mu; q += d * d; }
#pragma unroll
    for (int o = 32; o > 0; o >>= 1) q += __shfl_xor(q, o);
    const float rstd = 1.0f / sqrtf(q * (1.f / D) + LN_EPS);
    float* po = nullptr;
    if (last) {
      if (row < TPR) { const int b = row / LP, pos = row - b * LP; if (pos >= 16) po = p.out + O_YP + ((size_t)b * 2048 + pos - 16) * D; }
      else po = p.out + O_YS + (size_t)(row - TPR) * D;
    }
#pragma unroll
    for (int i = 0; i < 4; ++i) {
      f32x4 y;
#pragma unroll
      for (int j = 0; j < 4; ++j) y[j] = (v[i][j] - mu) * rstd * gv[i][j] + bv[i][j];
      *(f32x4*)(px + i * 256 + lane * 4) = y;
      u32x2 w; w[0] = pack2(y[0], y[1]); w[1] = pack2(y[2], y[3]);
      *(u32x2*)(p.Xb + (size_t)row * D + i * 256 + lane * 4) = w;
      if (po) *(f32x4*)(po + i * 256 + lane * 4) = y;
    }
  }
}

constexpr int VT_STRIDE = 164;
constexpr int SM_K = 0, SM_VT = 2 * 160 * 128, SM_BIAS = SM_VT + 2 * 64 * VT_STRIDE * 2;
constexpr int N_ATT_P = NB * 65, N_ATT_S = SB, N_CONV = T / 64;

DI void attn_item(const Params& p, int l, int item, char* smem, const int tid) {
  const int lane = tid & 63, wave = tid >> 6, r = lane & 31, h = lane >> 5;
  const bool samp = item >= N_ATT_P;
  int b, q0, seqlen;
  if (!samp) { b = item / 65; q0 = (item - b * 65) * 32; seqlen = LP; }
  else { b = item - N_ATT_P; q0 = 128; seqlen = 132; }
  const int rowbase = samp ? (TPR + b * 4 - 128) : b * LP;
  const float* sBias = (const float*)(smem + SM_BIAS);
#pragma unroll 1
  for (int idx = tid; idx < 2 * 160 * 8; idx += NT) {
    const int kvh = idx / 1280, rem = idx - kvh * 1280;
    const int j = rem >> 3, c = rem & 7; const int pos = q0 - 128 + j;
    u32x4 kv = {0u, 0u, 0u, 0u}, vv = {0u, 0u, 0u, 0u};
    if (pos >= 0 && pos < seqlen) {
      if (samp && pos < 128) {
        const size_t o = (((size_t)(l * SB + b) * 128 + pos) * 2 + kvh) * 64 + c * 8;
        const f32x4 k0 = *(const f32x4*)(p.cache_k + o), k1 = *(const f32x4*)(p.cache_k + o + 4);
        const f32x4 v0 = *(const f32x4*)(p.cache_v + o), v1 = *(const f32x4*)(p.cache_v + o + 4);
        kv[0] = pack2(k0[0], k0[1]); kv[1] = pack2(k0[2], k0[3]); kv[2] = pack2(k1[0], k1[1]); kv[3] = pack2(k1[2], k1[3]);
        vv[0] = pack2(v0[0], v0[1]); vv[1] = pack2(v0[2], v0[3]); vv[2] = pack2(v1[0], v1[1]); vv[3] = pack2(v1[2], v1[3]);
      } else {
        const bf16_t* src = p.P + (size_t)(rowbase + pos) * NPQ + 512 + kvh * 64 + c * 8;
        kv = *(const u32x4*)src; vv = *(const u32x4*)(src + 128);
      }
    }
    *(u32x4*)(smem + SM_K + kvh * 20480 + lds_off(j, c)) = kv;
    bf16_t* sVt = (bf16_t*)(smem + SM_VT) + kvh * 64 * VT_STRIDE;
#pragma unroll
    for (int e = 0; e < 4; ++e) {
      sVt[(c * 8 + 2 * e) * VT_STRIDE + j] = (bf16_t)(vv[e] & 0xffffu);
      sVt[(c * 8 + 2 * e + 1) * VT_STRIDE + j] = (bf16_t)(vv[e] >> 16);
    }
  }
  const int head = wave, kvh = wave >> 2;
  const char* sK = smem + SM_K + kvh * 20480; const bf16_t* sVt = (const bf16_t*)(smem + SM_VT) + kvh * 64 * VT_STRIDE;
  const int qpos = min(q0 + r, seqlen - 1);
  const bf16_t* qsrc = p.P + (size_t)(rowbase + qpos) * NPQ + head * 64 + 8 * h;
  bf16x8 qf[4];
#pragma unroll
  for (int s = 0; s < 4; ++s) qf[s] = *(const bf16x8*)(qsrc + 16 * s);
  __syncthreads();
  const float sink = p.sink[l * 8 + head];
  const int jmin = max(0, 128 - q0);
  float m = sink;
  f32x16 acc[5];
#pragma unroll
  for (int kt = 0; kt < 5; ++kt) {
#pragma unroll
    for (int i = 0; i < 16; ++i) acc[kt][i] = 0.f;
#pragma unroll
    for (int s = 0; s < 4; ++s) {
      const bf16x8 kf = *(const bf16x8*)(sK + lds_off(32 * kt + r, 2 * s + h));
      acc[kt] = MFMA32(kf, qf[s], acc[kt]);
    }
    const float* bp = sBias + head * 132 + r + 128 - 32 * kt - 4 * h;
#pragma unroll
    for (int i = 0; i < 16; ++i) {
      const int jo = 8 * (i >> 2) + (i & 3);
      const int j = 32 * kt + 4 * h + jo;
      const int d = r + 128 - j;
      const bool valid = (d >= 0) && (d <= 128) && (j >= jmin);
      const float bias = bp[valid ? -jo : (-jo - d)];
      const float sv = valid ? acc[kt][i] * 0.125f + bias : -INFINITY;
      acc[kt][i] = sv; m = fmaxf(m, sv);
    }
    __builtin_amdgcn_sched_barrier(0);
  }
  m = fmaxf(m, __shfl_xor(m, 32));
  float sum = 0.f;
#pragma unroll
  for (int kt = 0; kt < 5; ++kt)
#pragma unroll
    for (int i = 0; i < 16; ++i) { const float e = __expf(acc[kt][i] - m); acc[kt][i] = e; sum += e; }
  sum += __shfl_xor(sum, 32);
  const float inv = 1.f / (sum + __expf(sink - m));
  f32x16 o[2];
#pragma unroll
  for (int dt = 0; dt < 2; ++dt)
#pragma unroll
    for (int i = 0; i < 16; ++i) o[dt][i] = 0.f;
#pragma unroll
  for (int kt = 0; kt < 5; ++kt)
#pragma unroll
    for (int s2 = 0; s2 < 2; ++s2) {
      u32x4 pw;
#pragma unroll
      for (int e = 0; e < 4; ++e) pw[e] = pack2(acc[kt][8 * s2 + 2 * e], acc[kt][8 * s2 + 2 * e + 1]);
      const bf16x8 pf = __builtin_bit_cast(bf16x8, pw);
#pragma unroll
      for (int dt = 0; dt < 2; ++dt) {
        const bf16_t* vp = sVt + (dt * 32 + r) * VT_STRIDE + 32 * kt + 16 * s2 + 4 * h;
        const s16x4 lo = *(const s16x4*)vp, hi = *(const s16x4*)(vp + 8);
        const bf16x8 vf = __builtin_shufflevector(lo, hi, 0, 1, 2, 3, 4, 5, 6, 7);
        o[dt] = MFMA32(vf, pf, o[dt]);
      }
      __builtin_amdgcn_sched_barrier(0);
    }
  if (q0 + r < seqlen) {
    bf16_t* dst = p.MIX + (size_t)(rowbase + q0 + r) * D + head * 64 + 4 * h;
#pragma unroll
    for (int dt = 0; dt < 2; ++dt)
#pragma unroll
      for (int g = 0; g < 4; ++g) {
        u32x2 v; v[0] = pack2(o[dt][4 * g] * inv, o[dt][4 * g + 1] * inv); v[1] = pack2(o[dt][4 * g + 2] * inv, o[dt][4 * g + 3] * inv);
        *(u32x2*)(dst + dt * 32 + 8 * g) = v;
      }
  }
  __syncthreads();
}

DI void unpack8(const u32x4 v, float* f) {
#pragma unroll
  for (int e = 0; e < 4; ++e) { f[2 * e] = bflo(v[e]); f[2 * e + 1] = bfhi(v[e]); }
}

DI void conv_item(const Params& p, int l, int item, const int tid) {
  const int c = (tid & 63) * 8, rs = tid >> 6;
  const float* cw = p.conv_w + (size_t)l * 3 * 512 + c;
  float w0[8], w1[8], w2[8];
#pragma unroll
  for (int e = 0; e < 8; ++e) { w0[e] = cw[e]; w1[e] = cw[512 + e]; w2[e] = cw[1024 + e]; }
#pragma unroll 2
  for (int i = 0; i < 8; ++i) {
    const int row = item * 64 + rs + 8 * i;
    float u0[8], u1[8], u2[8], bg[8];
    unpack8(*(const u32x4*)(p.U + (size_t)row * 512 + c), u2);
    unpack8(*(const u32x4*)(p.P + (size_t)row * NPQ + 768 + c), bg);
    if (row < TPR) {
      const int pos = row % LP;
      if (pos >= 1) unpack8(*(const u32x4*)(p.U + (size_t)(row - 1) * 512 + c), u1); else { for (int e = 0; e < 8; ++e) u1[e] = 0.f; }
      if (pos >= 2) unpack8(*(const u32x4*)(p.U + (size_t)(row - 2) * 512 + c), u0); else { for (int e = 0; e < 8; ++e) u0[e] = 0.f; }
    } else {
      const int sb = (row - TPR) >> 2, t = (row - TPR) & 3;
      const float* st = p.state_conv + (size_t)(l * SB + sb) * 2 * 512 + c;
      if (t >= 1) unpack8(*(const u32x4*)(p.U + (size_t)(row - 1) * 512 + c), u1); else { for (int e = 0; e < 8; ++e) u1[e] = st[512 + e]; }
      if (t >= 2) unpack8(*(const u32x4*)(p.U + (size_t)(row - 2) * 512 + c), u0); else { for (int e = 0; e < 8; ++e) u0[e] = st[t * 512 + e]; }
    }
    u32x4 ov;
#pragma unroll
    for (int e = 0; e < 4; ++e) {
      const float a = bg[2 * e] * (w0[2 * e] * u0[2 * e] + w1[2 * e] * u1[2 * e] + w2[2 * e] * u2[2 * e]);
      const float bq = bg[2 * e + 1] * (w0[2 * e + 1] * u0[2 * e + 1] + w1[2 * e + 1] * u1[2 * e + 1] + w2[2 * e + 1] * u2[2 * e + 1]);
      ov[e] = pack2(a, bq);
    }
    *(u32x4*)(p.MIX + (size_t)row * D + 512 + c) = ov;
  }
}

DI void mix_phase(const Params& p, int l, char* smem, int bid, int nb, const int tid) {
  float* sBias = (float*)(smem + SM_BIAS);
  for (int i = tid; i < 8 * 129; i += NT) {
    const int hd = i / 129, d = i - hd * 129;
    int bk;
    if (d < 16) bk = d; else { bk = 16 + (int)(log2f((float)d * (1.f / 16.f)) * (16.f / 3.f) + 1e-4f); bk = min(bk, 31); }
    sBias[hd * 132 + d] = p.rel_bias[bk * 8 + hd];
  }
  __syncthreads();
  const int total = N_ATT_P + N_ATT_S + N_CONV;
  for (int it = bid; it < total; it += nb) {
    if (it < N_ATT_P + N_ATT_S) attn_item(p, l, it, smem, tid);
    else conv_item(p, l, it - (N_ATT_P + N_ATT_S), tid);
  }
  __syncthreads();
}

__global__ void __launch_bounds__(512, 2) mk_forward(Params p) {
  extern __shared__ __attribute__((aligned(16))) unsigned char lds[];
  char* smem = (char*)lds;
  const int nb = gridDim.x, bid = blockIdx.x;
  for (int ph = p.phase_lo; ph < p.phase_hi; ++ph) {
    int tid = threadIdx.x; asm volatile("" : "+v"(tid));
    if (ph == 0) { if (!(DISABLE & 1)) prep_phase(p, bid, nb, tid); }
    else {
      const int l = (ph - 1) / 10, s = (ph - 1) % 10;
      switch (s) {
        case 0: case 7: if (!(DISABLE & 2)) {
          const int f = s == 0 ? 0 : 1;
          EpiGU e{p.H};
          run_gemm(lds, p.Xb, p.Wgu + (size_t)(l * 2 + f) * 2 * DFF * D, 2 * DFF, D, e, tid);
        } break;
        case 1: case 8: if (!(DISABLE & 4)) {
          const int f = s == 1 ? 0 : 1;
          EpiRes e{p.Xf, 0.5f};
          run_gemm(lds, p.H, p.Wd + (size_t)(l * 2 + f) * D * DFF, D, DFF, e, tid);
        } break;
        case 2: if (!(DISABLE & 8)) ln_phase(p, l * 3 + 0, false, bid, nb, tid); break;
        case 6: if (!(DISABLE & 8)) ln_phase(p, l * 3 + 1, false, bid, nb, tid); break;
        case 9: if (!(DISABLE & 8)) ln_phase(p, l * 3 + 2, l == DEPTH - 1, bid, nb, tid); break;
        case 3: if (!(DISABLE & 16)) {
          EpiIn e{p.P, p.U, p.out, l};
          run_gemm(lds, p.Xb, p.Win + (size_t)l * DIN * D, DIN, D, e, tid);
        } break;
        case 4: if (!(DISABLE & 32)) mix_phase(p, l, smem, bid, nb, tid); break;
        case 5: if (!(DISABLE & 64)) {
          EpiRes e{p.Xf, 1.0f};
          run_gemm(lds, p.MIX, p.Wout + (size_t)l * D * D, D, D, e, tid);
        } break;
      }
    }
    if (ph + 1 < p.phase_hi) cg::this_grid().sync();
  }
}

extern "C" void kernel_launch(void* const* d_in, const int* in_sizes, int n_in, void* d_out, int out_size, void* d_ws, size_t ws_size, hipStream_t stream) {
  static int grid_blocks = 0;
  if (!grid_blocks) {
    int dev = 0, cus = 0, per_cu = 0;
    (void)hipGetDevice(&dev);
    (void)hipDeviceGetAttribute(&cus, hipDeviceAttributeMultiprocessorCount, dev);
    if (hipFuncSetAttribute((const void*)mk_forward, hipFuncAttributeMaxDynamicSharedMemorySize, LDS_BYTES) != hipSuccess) fprintf(stderr, "hipFuncSetAttribute failed\n");
    (void)hipOccupancyMaxActiveBlocksPerMultiprocessor(&per_cu, mk_forward, NT, LDS_BYTES);
    if (per_cu < 1) fprintf(stderr, "occupancy query says %d blocks per CU\n", per_cu);
    grid_blocks = cus;
  }
  Params p{};
  p.x_prompt = (const float*)d_in[0]; p.x_sample = (const float*)d_in[1]; p.cache_k = (const float*)d_in[2]; p.cache_v = (const float*)d_in[3];
  p.state_conv = (const float*)d_in[4]; p.meta = (const float*)d_in[5]; p.rel_bias = (const float*)d_in[6]; p.w_in = (const float*)d_in[7];
  p.conv_w = (const float*)d_in[8]; p.sink = (const float*)d_in[9]; p.w_out = (const float*)d_in[10]; p.w_gate = (const float*)d_in[11];
  p.w_up = (const float*)d_in[12]; p.w_down = (const float*)d_in[13]; p.ln_g = (const float*)d_in[14]; p.ln_b = (const float*)d_in[15];
  p.out = (float*)d_out;
  char* w = (char*)d_ws; size_t off = 0;
  auto take = [&](size_t bytes) { char* q = w + off; off += (bytes + 255) & ~(size_t)255; return q; };
  p.Wgu = (bf16_t*)take((size_t)DEPTH * 2 * 2 * DFF * D * 2);
  p.Wd = (bf16_t*)take((size_t)DEPTH * 2 * D * DFF * 2);
  p.Win = (bf16_t*)take((size_t)DEPTH * DIN * D * 2);
  p.Wout = (bf16_t*)take((size_t)DEPTH * D * D * 2);
  p.Xf = (float*)take((size_t)TPAD * D * 4);
  p.Xb = (bf16_t*)take((size_t)TPAD * D * 2);
  p.H = (bf16_t*)take((size_t)TPAD * DFF * 2);
  p.P = p.H; p.U = p.P + (size_t)T * NPQ; p.MIX = p.U + (size_t)T * 512;
  const int NPH = 1 + 10 * DEPTH;
#if MK_MULTI
  for (int ph = 0; ph < NPH; ++ph) {
    p.phase_lo = ph; p.phase_hi = ph + 1;
    hipLaunchKernelGGL(mk_forward, dim3(grid_blocks), dim3(NT), LDS_BYTES, stream, p);
  }
#else
  p.phase_lo = 0; p.phase_hi = NPH;
  void* args[] = {&p};
  hipError_t e = hipLaunchCooperativeKernel((void*)mk_forward, dim3(grid_blocks), dim3(NT), args, LDS_BYTES, stream);
  if (e != hipSuccess) fprintf(stderr, "cooperative launch failed: %s (grid %d)\n", hipGetErrorString(e), grid_blocks);
#endif
}
```

```cpp
#include <hip/hip_runtime.h>
#include <hip/hip_cooperative_groups.h>
#include <cstdio>
namespace cg = cooperative_groups;

#ifndef MK_MULTI
#define MK_MULTI 0
#endif
#ifndef DISABLE
#define DISABLE 0
#endif
#define DI __device__ __forceinline__
namespace pg8 {
#define PG8_LAS __attribute__((address_space(3)))
typedef unsigned short bf16_t;
typedef short bf16x8 __attribute__((ext_vector_type(8)));
typedef float f32x4 __attribute__((ext_vector_type(4)));
typedef unsigned u32x4 __attribute__((ext_vector_type(4)));
constexpr int BM = 256, BK = 64, HALF = 128, HTB = HALF * BK * 2  , STAGE_BYTES = 8 * HTB, NXCD = 8, WGM = 8;

__host__ __device__ __forceinline__ int lds_byte(int r, int c) { const int st = (r >> 4) * 2 + (c >> 5), rr = r & 15, cc = c & 31, ob = rr * 64 + cc * 2; return st * 1024 + (ob ^ (((ob >> 9) & 1) << 5)); }
__host__ __device__ __forceinline__ void stage_rc(int b, int& R, int& C) { const int st = b / 1024, sb = b % 1024, swz = sb ^ (((sb >> 9) & 1) << 5); R = (st >> 1) * 16 + swz / 64; C = (st & 1) * 32 + (swz % 64) / 2; }
__host__ __device__ __forceinline__ int perm32(int rho) { const int n = rho >> 4, i = rho & 15; return 8 * (i >> 2) + 4 * n + (i & 3); }

struct Unit { int pm, pn, kt0, nt, split; };
struct Gemm { const bf16_t* A; const bf16_t* Bt; int M, N, K; };

struct StaticOrder {
    int nM, nN, nwg, G, c, ntk;
    __host__ __device__ void init(int M, int N, int K, int G_, int c_) { nM = M / BM; nN = N / BM; nwg = nM * nN; G = G_; c = c_; ntk = K / BK; }
    __host__ __device__ bool next(int i, Unit& u) const {
        const long L = (long)i * G + c; if (L >= nwg) return false;
        int wgid = (int)L; { const int q = nwg / NXCD, r = nwg % NXCD, xcd = wgid % NXCD, off = wgid / NXCD; wgid = (xcd < r ? xcd * (q + 1) : r * (q + 1) + (xcd - r) * q) + off; }
        const int nig = WGM * nN, gid = wgid / nig, fm = gid * WGM, gsz = (nM - fm) < WGM ? (nM - fm) : WGM;
        u.pm = fm + ((wgid % nig) % gsz); u.pn = (wgid % nig) / gsz; u.kt0 = 0; u.nt = ntk; u.split = 0; return true;
    }
    __device__ __forceinline__ void a_ready(const Unit&) const {}
    __device__ __forceinline__ void done(const Unit&) const {}
};

template <class Epi, class Sched, bool STAMP = false>
__device__ __forceinline__ void gemm_phase(PG8_LAS unsigned char* lds, const Gemm g, const Sched& S, const Epi& E, unsigned long long* stamps, const int tid) {
    const int wid = __builtin_amdgcn_readfirstlane(tid >> 6), lane = tid & 63, wr = wid >> 2, wc = wid & 3, fr = lane & 15, fq = lane >> 4;
    const int K = g.K;
    int ts_lo = 0, ts_hi = 0, nts = 0; const unsigned long long rt_entry = STAMP ? (unsigned long long)wall_clock64() : 0ull;
#define PG8_STAMP() do { if (STAMP && wid == 0 && nts < 64) { const unsigned long long _c = (unsigned long long)clock64(); \
        ts_lo = (lane == nts) ? (int)(unsigned)_c : ts_lo; ts_hi = (lane == nts) ? (int)(unsigned)(_c >> 32) : ts_hi; ++nts; } } while (0)
    PG8_STAMP();
    unsigned voffA[2], voffB[2];
#pragma unroll
    for (int i = 0; i < 2; ++i) { int R, C; stage_rc(tid * 16 + i * 8192, R, C); const int Rb = Epi::PERM ? ((R & ~31) + perm32(R & 31)) : R;
        voffA[i] = (unsigned)(R * K + C) * 2u; voffB[i] = (unsigned)(Rb * K + C) * 2u; }
    const size_t kstep = (size_t)(BK * 2);
    const size_t hstep = (size_t)HALF * K * 2;
    const size_t tstep = 2 * hstep;
    const unsigned ldsw = (unsigned)wid * 1024u;
    const int aoff = lds_byte(wr * 64 + fr, fq * 8), boff = lds_byte(wc * 32 + fr, fq * 8);
#define PG8_SA(b, h) (((b) * 2 + (h)) * HTB)
#define PG8_SB(b, h) ((4 + (b) * 2 + (h)) * HTB)
#define PG8_STAGE(bufoff, gbase, voff) do { _Pragma("unroll") for (int _i = 0; _i < 2; ++_i) \
        __builtin_amdgcn_global_load_lds((const unsigned*)((const char*)(gbase) + (voff)[_i]), (PG8_LAS unsigned*)(lds + (bufoff) + ldsw + _i * 8192), 16, 0, 0); } while (0)
#define PG8_LDA(dst, b, h) do { _Pragma("unroll") for (int m = 0; m < 4; ++m) _Pragma("unroll") for (int k = 0; k < 2; ++k) dst[m][k] = *(const PG8_LAS bf16x8*)(lds + PG8_SA(b, h) + aoff + m * 2048 + k * 1024); } while (0)
#define PG8_LDB(dst, b, h) do { _Pragma("unroll") for (int n = 0; n < 2; ++n) _Pragma("unroll") for (int k = 0; k < 2; ++k) dst[n][k] = *(const PG8_LAS bf16x8*)(lds + PG8_SB(b, h) + boff + n * 2048 + k * 1024); } while (0)
#define PG8_MMA(ai, bj, At, Bt) do { __builtin_amdgcn_s_setprio(1); _Pragma("unroll") for (int m = 0; m < 4; ++m) _Pragma("unroll") for (int n = 0; n < 2; ++n) _Pragma("unroll") for (int k = 0; k < 2; ++k) \
        acc[ai][bj][m][n] = __builtin_amdgcn_mfma_f32_16x16x32_bf16(Bt[n][k], At[m][k], acc[ai][bj][m][n], 0, 0, 0); __builtin_amdgcn_s_setprio(0); } while (0)
#define PG8_WAIT_V(n) asm volatile("s_waitcnt vmcnt(" #n ")" ::: "memory")
#define PG8_WAIT_L(n) asm volatile("s_waitcnt lgkmcnt(" #n ")" ::: "memory")
#define PG8_BAR __builtin_amdgcn_s_barrier()
#define PG8_SCHED __builtin_amdgcn_sched_barrier(0)
    Unit cur, nxt; int ui = 0;
    if (!S.next(0, cur)) return;
    f32x4 acc[2][2][4][2];
#pragma unroll
    for (int a = 0; a < 2; ++a)
#pragma unroll
        for (int b = 0; b < 2; ++b)
#pragma unroll
            for (int m = 0; m < 4; ++m)
#pragma unroll
                for (int n = 0; n < 2; ++n) acc[a][b][m][n] = (f32x4){0.f, 0.f, 0.f, 0.f};
    bf16x8 At[4][2], B0[2][2], B1[2][2];
    const char* cA = (const char*)g.A + (size_t)cur.pm * tstep + (size_t)cur.kt0 * kstep; const char* cB = (const char*)g.Bt + (size_t)cur.pn * tstep + (size_t)cur.kt0 * kstep;
    S.a_ready(cur);
    PG8_STAGE(PG8_SB(0, 0), cB, voffB); PG8_STAGE(PG8_SA(0, 0), cA, voffA); PG8_STAGE(PG8_SB(0, 1), cB + hstep, voffB); PG8_STAGE(PG8_SA(0, 1), cA + hstep, voffA);
    if (wr == 1) PG8_BAR;
    PG8_WAIT_V(4); PG8_BAR;
    PG8_STAGE(PG8_SB(1, 0), cB + kstep, voffB); PG8_STAGE(PG8_SA(1, 0), cA + kstep, voffA); PG8_STAGE(PG8_SB(1, 1), cB + hstep + kstep, voffB);
    PG8_WAIT_V(6); PG8_BAR;
    PG8_STAMP();
    for (;;) {
        const bool has_next = S.next(ui + 1, nxt);
        const char* nA = has_next ? (const char*)g.A + (size_t)nxt.pm * tstep + (size_t)nxt.kt0 * kstep : cA; const char* nB = has_next ? (const char*)g.Bt + (size_t)nxt.pn * tstep + (size_t)nxt.kt0 * kstep : cB;
        const int nt = cur.nt;
        for (int t = 0; t < nt; t += 2) {
            const bool last = (t == nt - 2);
            const char* a1 = cA + (size_t)(t + 1) * kstep;
            const char* a2 = last ? nA : cA + (size_t)(t + 2) * kstep; const char* b2 = last ? nB : cB + (size_t)(t + 2) * kstep;
            const char* a3 = a2 + kstep; const char* b3 = b2 + kstep;
            if (last && has_next) S.a_ready(nxt);
            PG8_LDB(B0, 0, 0); PG8_SCHED; PG8_LDA(At, 0, 0); PG8_STAGE(PG8_SA(1, 1), a1 + hstep, voffA);
            PG8_WAIT_L(8); PG8_BAR; PG8_WAIT_L(0); PG8_MMA(0, 0, At, B0); PG8_BAR; PG8_SCHED;
            PG8_LDB(B1, 0, 1); PG8_STAGE(PG8_SB(0, 0), b2, voffB);
            PG8_BAR; PG8_WAIT_L(0); PG8_MMA(0, 1, At, B1); PG8_BAR;
            PG8_LDA(At, 0, 1); PG8_STAGE(PG8_SA(0, 0), a2, voffA);
            PG8_BAR; PG8_WAIT_L(0); PG8_MMA(1, 0, At, B0); PG8_BAR; PG8_SCHED;
            PG8_STAGE(PG8_SB(0, 1), b2 + hstep, voffB);
            PG8_WAIT_V(6); PG8_BAR; PG8_MMA(1, 1, At, B1); PG8_BAR;
            PG8_LDB(B0, 1, 0); PG8_SCHED; PG8_LDA(At, 1, 0); PG8_STAGE(PG8_SA(0, 1), a2 + hstep, voffA);
            PG8_WAIT_L(8); PG8_BAR; PG8_WAIT_L(0); PG8_MMA(0, 0, At, B0); PG8_BAR; PG8_SCHED;
            PG8_LDB(B1, 1, 1); PG8_STAGE(PG8_SB(1, 0), b3, voffB);
            PG8_BAR; PG8_WAIT_L(0); PG8_MMA(0, 1, At, B1); PG8_BAR;
            PG8_LDA(At, 1, 1); PG8_STAGE(PG8_SA(1, 0), a3, voffA);
            PG8_BAR; PG8_WAIT_L(0); PG8_MMA(1, 0, At, B0); PG8_BAR; PG8_SCHED;
            PG8_STAGE(PG8_SB(1, 1), b3 + hstep, voffB);
            PG8_WAIT_V(6); PG8_BAR; PG8_MMA(1, 1, At, B1); PG8_BAR;
        }
        PG8_STAMP();
        if constexpr (!Epi::AFTER_DRAIN) { E(acc, cur, wr, wc, fr, fq); S.done(cur); }
        PG8_STAMP();
        if (!has_next) break;
#pragma unroll
        for (int a = 0; a < 2; ++a)
#pragma unroll
            for (int b = 0; b < 2; ++b)
#pragma unroll
                for (int m = 0; m < 4; ++m)
#pragma unroll
                    for (int n = 0; n < 2; ++n) acc[a][b][m][n] = (f32x4){0.f, 0.f, 0.f, 0.f};
        cur = nxt; cA = nA; cB = nB; ++ui;
    }
    PG8_WAIT_V(0);
    if (wr == 0) PG8_BAR;
    PG8_BAR;
    if constexpr (Epi::AFTER_DRAIN) { E.fused(acc, cur, wr, wc, fr, fq, lds, wid, lane); S.done(cur); }
    PG8_STAMP();
    if (STAMP && wid == 0) { stamps[lane] = lane < nts ? (((unsigned long long)(unsigned)ts_hi << 32) | (unsigned)ts_lo) : 0ull;
        if (lane == 62) stamps[62] = rt_entry; if (lane == 63) stamps[63] = (unsigned long long)wall_clock64(); }
#undef PG8_STAMP
#undef PG8_SA
#undef PG8_SB
#undef PG8_STAGE
#undef PG8_LDA
#undef PG8_LDB
#undef PG8_MMA
#undef PG8_WAIT_V
#undef PG8_WAIT_L
#undef PG8_BAR
#undef PG8_SCHED
}
}


using pg8::bf16_t; using pg8::bf16x8; using pg8::f32x4; using pg8::u32x4;
typedef short s16x4 __attribute__((ext_vector_type(4)));
typedef float f32x16 __attribute__((ext_vector_type(16)));
typedef unsigned u32x2 __attribute__((ext_vector_type(2)));

constexpr int D = 1024, DFF = 2816, DEPTH = 4;
constexpr int LP = 2064, NB = 8, TPR = NB * LP;
constexpr int SB = 128, ST = 4, TSR = SB * ST;
constexpr int T = TPR + TSR;
constexpr int TPAD = 17152;
constexpr int NPQ = 1280;
constexpr int DIN = 2304;
constexpr float ALPHA = 1.681792830507429f;
constexpr float LN_EPS = 1e-5f;
constexpr int LDS_BYTES = 131072;
constexpr int NT = 512;
constexpr int SPLIT_ROW0 = 16384, SPLIT_ROWS = 768;

struct Params {
  const float* x_prompt; const float* x_sample; const float* cache_k; const float* cache_v; const float* state_conv;
  const float* meta; const float* rel_bias; const float* w_in; const float* conv_w; const float* sink;
  const float* w_out; const float* w_gate; const float* w_up; const float* w_down; const float* ln_g; const float* ln_b;
  float* out;
  bf16_t* Wgu; bf16_t* Wd; bf16_t* Win; bf16_t* Wout;
  float* Xf; float* Part; bf16_t* Xb; bf16_t* H; bf16_t* P; bf16_t* U; bf16_t* MIX;
  int phase_lo, phase_hi;
};

constexpr size_t O_YP = 0;
constexpr size_t O_YS = O_YP + (size_t)8 * 2048 * 1024;
constexpr size_t O_KP = O_YS + (size_t)512 * 1024;
constexpr size_t O_VP = O_KP + (size_t)4 * 8 * 128 * 128;
constexpr size_t O_CP = O_VP + (size_t)4 * 8 * 128 * 128;
constexpr size_t O_KS = O_CP + (size_t)4 * 8 * 2 * 512;
constexpr size_t O_VS = O_KS + (size_t)4 * 128 * 128 * 128;
constexpr size_t O_CS = O_VS + (size_t)4 * 128 * 128 * 128;

DI unsigned f2bf(float x) { unsigned u = __float_as_uint(x); u += 0x7fffu + ((u >> 16) & 1u); return u >> 16; }
DI unsigned pack2(float lo, float hi) { return f2bf(lo) | (f2bf(hi) << 16); }
DI float bflo(unsigned v) { return __uint_as_float(v << 16); }
DI float bfhi(unsigned v) { return __uint_as_float(v & 0xffff0000u); }

#define MFMA32(a, b, c) __builtin_amdgcn_mfma_f32_32x32x16_bf16((a), (b), (c), 0, 0, 0)

DI int lds_off(int row, int chunk) { return row * 128 + ((chunk ^ ((row >> 1) & 7)) << 4); }

struct EpiGU {
  static constexpr bool PERM = true, AFTER_DRAIN = false;
  bf16_t* H;
  DI void operator()(const f32x4 (&acc)[2][2][4][2], const pg8::Unit& u, int wr, int wc, int fr, int fq) const {
    const int row0 = u.pm * 256 + wr * 64 + fr, col0 = u.pn * 128 + wc * 32 + 8 * fq;
#pragma unroll
    for (int ai = 0; ai < 2; ++ai)
#pragma unroll
      for (int m = 0; m < 4; ++m) {
        const int row = row0 + ai * 128 + m * 16;
        if (row < T) {
          float o[8];
#pragma unroll
          for (int n = 0; n < 2; ++n)
#pragma unroll
            for (int j = 0; j < 4; ++j) { const float ga = acc[ai][0][m][n][j], up = acc[ai][1][m][n][j]; o[4 * n + j] = ga * up * __builtin_amdgcn_rcpf(1.f + __expf(-ga)); }
          u32x4 w; w[0] = pack2(o[0], o[1]); w[1] = pack2(o[2], o[3]); w[2] = pack2(o[4], o[5]); w[3] = pack2(o[6], o[7]);
          *(u32x4*)(H + (size_t)row * DFF + col0) = w;
        }
      }
  }
};
struct EpiRes {
  static constexpr bool PERM = false, AFTER_DRAIN = false;
  float* X; float* Part; float scale;
  DI void operator()(const f32x4 (&acc)[2][2][4][2], const pg8::Unit& u, int wr, int wc, int fr, int fq) const {
    const int row0 = u.pm * 256 + wr * 64 + fr, col0 = u.pn * 256 + wc * 32 + 4 * fq;
#pragma unroll
    for (int ai = 0; ai < 2; ++ai)
#pragma unroll
      for (int m = 0; m < 4; ++m) {
        const int row = row0 + ai * 128 + m * 16;
        if (row < T) {
          if (!u.split) {
            float* px = X + (size_t)row * D + col0;
#pragma unroll
            for (int bj = 0; bj < 2; ++bj)
#pragma unroll
              for (int n = 0; n < 2; ++n) {
                f32x4 x = *(const f32x4*)(px + bj * 128 + n * 16);
#pragma unroll
                for (int j = 0; j < 4; ++j) x[j] = ALPHA * x[j] + scale * acc[ai][bj][m][n][j];
                *(f32x4*)(px + bj * 128 + n * 16) = x;
              }
          } else {
            float* pp = Part + ((size_t)(u.split - 1) * SPLIT_ROWS + (row - SPLIT_ROW0)) * D + col0;
#pragma unroll
            for (int bj = 0; bj < 2; ++bj)
#pragma unroll
              for (int n = 0; n < 2; ++n) *(f32x4*)(pp + bj * 128 + n * 16) = acc[ai][bj][m][n] * scale;
          }
        }
      }
  }
};
struct EpiIn {
  static constexpr bool PERM = true, AFTER_DRAIN = false;
  bf16_t* P; bf16_t* U; float* out; int l;
  DI void operator()(const f32x4 (&acc)[2][2][4][2], const pg8::Unit& u, int wr, int wc, int fr, int fq) const {
    const int row0 = u.pm * 256 + wr * 64 + fr, cl = wc * 32 + 8 * fq;
#pragma unroll
    for (int ai = 0; ai < 2; ++ai)
#pragma unroll
      for (int m = 0; m < 4; ++m) {
        const int row = row0 + ai * 128 + m * 16;
        if (row >= T) continue;
        int b, pos; const bool samp = row >= TPR;
        if (!samp) { b = row / LP; pos = row - b * LP; } else { b = (row - TPR) >> 2; pos = (row - TPR) & 3; }
        if (u.pn < 5) {
#pragma unroll
          for (int bj = 0; bj < 2; ++bj) {
            const f32x4 v0 = acc[ai][bj][m][0], v1 = acc[ai][bj][m][1];
            u32x4 w; w[0] = pack2(v0[0], v0[1]); w[1] = pack2(v0[2], v0[3]); w[2] = pack2(v1[0], v1[1]); w[3] = pack2(v1[2], v1[3]);
            *(u32x4*)(P + (size_t)row * NPQ + u.pn * 256 + bj * 128 + cl) = w;
            if (u.pn == 2) {
              float* so = nullptr;
              if (!samp) { if (pos >= LP - 128) so = out + (bj ? O_VP : O_KP) + ((size_t)(l * NB + b) * 128 + (pos - (LP - 128))) * 128; }
              else so = out + (bj ? O_VS : O_KS) + ((size_t)(l * SB + b) * 128 + 124 + pos) * 128;
              if (so) { *(f32x4*)(so + cl) = v0; *(f32x4*)(so + cl + 4) = v1; }
            }
          }
        } else {
          f32x4 f0, f1;
#pragma unroll
          for (int j = 0; j < 4; ++j) { f0[j] = acc[ai][0][m][0][j] * acc[ai][1][m][0][j]; f1[j] = acc[ai][0][m][1][j] * acc[ai][1][m][1][j]; }
          const int c0 = (u.pn - 5) * 128 + cl;
          u32x4 w; w[0] = pack2(f0[0], f0[1]); w[1] = pack2(f0[2], f0[3]); w[2] = pack2(f1[0], f1[1]); w[3] = pack2(f1[2], f1[3]);
          *(u32x4*)(U + (size_t)row * 512 + c0) = w;
          float* so = nullptr;
          if (!samp) { if (pos >= LP - 2) so = out + O_CP + ((size_t)(l * NB + b) * 2 + (pos - (LP - 2))) * 512; }
          else if (pos >= 2) so = out + O_CS + ((size_t)(l * SB + b) * 2 + (pos - 2)) * 512;
          if (so) { *(f32x4*)(so + c0) = f0; *(f32x4*)(so + c0 + 4) = f1; }
        }
      }
  }
};

template <class Epi>
DI void run_gemm(unsigned char* lds, const bf16_t* A, const bf16_t* Bt, int N, int K, const Epi& e, const int tid) {
  pg8::Gemm g; g.A = A; g.Bt = Bt; g.M = TPAD; g.N = N; g.K = K;
  pg8::StaticOrder S; S.init(TPAD, N, K, (int)gridDim.x, (int)blockIdx.x);
  pg8::gemm_phase<Epi, pg8::StaticOrder, false>((PG8_LAS unsigned char*)lds, g, S, e, nullptr, tid);
}


struct SplitOrder {
  pg8::StaticOrder base; int S, c;
  DI void init(int N, int K, int G, int c_, int S_) { base.init(16384, N, K, G, c_); S = S_; c = c_; }
  DI bool next(int i, pg8::Unit& u) const {
    if (i == 0) return base.next(0, u);
    if (i == 1 && c < 12 * S) { const int j = c / S, sl = c - j * S; u.pm = 64 + (j >> 2); u.pn = j & 3; u.nt = base.ntk / S; u.kt0 = sl * u.nt; u.split = 1 + sl; return true; }
    return false;
  }
  DI void a_ready(const pg8::Unit&) const {}
  DI void done(const pg8::Unit&) const {}
};
template <class Epi>
DI void run_gemm_split(unsigned char* lds, const bf16_t* A, const bf16_t* Bt, int N, int K, int S, const Epi& e, const int tid) {
  pg8::Gemm g; g.A = A; g.Bt = Bt; g.M = TPAD; g.N = N; g.K = K;
  SplitOrder O; O.init(N, K, (int)gridDim.x, (int)blockIdx.x, S);
  pg8::gemm_phase<Epi, SplitOrder, false>((PG8_LAS unsigned char*)lds, g, O, e, nullptr, tid);
}

DI void transpose_unit(const float* __restrict__ src, int ld_src, int c0, int k0, bf16_t* __restrict__ dst, int K, int s0, const int tid) {
  const int lane = tid & 63, wave = tid >> 6;
  const float* s = src + (size_t)(k0 + 32 * wave) * ld_src + c0 + lane;
  bf16_t* d = dst + (size_t)(s0 + lane) * K + k0 + 32 * wave;
  float v[32];
#pragma unroll
  for (int e = 0; e < 32; ++e) v[e] = s[(size_t)e * ld_src];
#pragma unroll
  for (int g = 0; g < 4; ++g) {
    u32x4 w; w[0] = pack2(v[8 * g], v[8 * g + 1]); w[1] = pack2(v[8 * g + 2], v[8 * g + 3]); w[2] = pack2(v[8 * g + 4], v[8 * g + 5]); w[3] = pack2(v[8 * g + 6], v[8 * g + 7]);
    *(u32x4*)(d + 8 * g) = w;
  }
}

DI void prep_phase(const Params& p, int bid, int nb, const int tid) {
  constexpr int U_GU = 88 * 4, U_D = 16 * 11, U_IN = 36 * 4, U_OUT = 16 * 4;
  constexpr int U_L = 2 * U_GU + 2 * U_D + U_IN + U_OUT;
  for (int u = bid; u < DEPTH * U_L; u += nb) {
    const int l = u / U_L; int rem = u - l * U_L;
    if (rem < 2 * U_GU) {
      const int f = rem / U_GU; rem -= f * U_GU; const int sg = rem >> 2, ku = rem & 3;
      const int tile = sg >> 2, q = sg & 3;
      const float* src = ((q >> 1) ? p.w_up : p.w_gate) + (size_t)(l * 2 + f) * D * DFF;
      transpose_unit(src, DFF, tile * 128 + (q & 1) * 64, ku * 256, p.Wgu + (size_t)(l * 2 + f) * 2 * DFF * D, D, sg * 64, tid);
    } else if (rem < 2 * U_GU + 2 * U_D) {
      rem -= 2 * U_GU; const int f = rem / U_D; rem -= f * U_D; const int sg = rem / 11, ku = rem % 11;
      transpose_unit(p.w_down + (size_t)(l * 2 + f) * DFF * D, D, sg * 64, ku * 256, p.Wd + (size_t)(l * 2 + f) * D * DFF, DFF, sg * 64, tid);
    } else if (rem < 2 * U_GU + 2 * U_D + U_IN) {
      rem -= 2 * U_GU + 2 * U_D; const int sg = rem >> 2, ku = rem & 3;
      int c0;
      if (sg < 20) c0 = sg * 64; else { const int g = sg - 20, i = g >> 2, q = g & 3; c0 = ((q >> 1) ? 1792 : 1280) + 128 * i + (q & 1) * 64; }
      transpose_unit(p.w_in + (size_t)l * D * DIN, DIN, c0, ku * 256, p.Win + (size_t)l * DIN * D, D, sg * 64, tid);
    } else {
      rem -= 2 * U_GU + 2 * U_D + U_IN; const int sg = rem >> 2, ku = rem & 3;
      transpose_unit(p.w_out + (size_t)l * D * D, D, sg * 64, ku * 256, p.Wout + (size_t)l * D * D, D, sg * 64, tid);
    }
  }
  const int gt = bid * NT + tid, ngt = nb * NT;
  for (int i = gt; i < T * (D / 4); i += ngt) {
    const int row = i >> 8, c = (i & 255) * 4;
    const float* src;
    if (row < TPR) { const int b = row / LP, pos = row - b * LP; src = pos < 16 ? p.meta + (size_t)pos * D : p.x_prompt + ((size_t)b * 2048 + pos - 16) * D; }
    else src = p.x_sample + (size_t)(row - TPR) * D;
    const f32x4 v = *(const f32x4*)(src + c);
    *(f32x4*)(p.Xf + (size_t)row * D + c) = v;
    u32x2 w; w[0] = pack2(v[0], v[1]); w[1] = pack2(v[2], v[3]);
    *(u32x2*)(p.Xb + (size_t)row * D + c) = w;
  }
  constexpr int PER = 124 * 128 / 4;
  for (int i = gt; i < 2 * DEPTH * SB * PER; i += ngt) {
    const int kv = i / (DEPTH * SB * PER); int rem = i - kv * (DEPTH * SB * PER);
    const int lb = rem / PER; const int e = rem - lb * PER;
    const float* src = (kv ? p.cache_v : p.cache_k) + (size_t)lb * 128 * 128 + 4 * 128 + (size_t)e * 4;
    float* dst = p.out + (kv ? O_VS : O_KS) + (size_t)lb * 128 * 128 + (size_t)e * 4;
    *(f32x4*)dst = *(const f32x4*)src;
  }
}

DI void ln_phase(const Params& p, int lnidx, bool last, int nsplit, int bid, int nb, const int tid) {
  const int lane = tid & 63;
  const int gw = bid * (NT / 64) + (tid >> 6), nw = nb * (NT / 64);
  const float* g = p.ln_g + (size_t)lnidx * D; const float* bb = p.ln_b + (size_t)lnidx * D;
  f32x4 gv[4], bv[4];
#pragma unroll
  for (int i = 0; i < 4; ++i) { gv[i] = *(const f32x4*)(g + i * 256 + lane * 4); bv[i] = *(const f32x4*)(bb + i * 256 + lane * 4); }
  for (int row = gw; row < T; row += nw) {
    float* px = p.Xf + (size_t)row * D;
    f32x4 v[4];
#pragma unroll
    for (int i = 0; i < 4; ++i) v[i] = *(const f32x4*)(px + i * 256 + lane * 4);
    if (row >= SPLIT_ROW0) {
#pragma unroll
      for (int i = 0; i < 4; ++i) v[i] *= ALPHA;
      for (int sl = 0; sl < nsplit; ++sl) {
        const float* pp = p.Part + ((size_t)sl * SPLIT_ROWS + (row - SPLIT_ROW0)) * D;
#pragma unroll
        for (int i = 0; i < 4; ++i) v[i] += *(const f32x4*)(pp + i * 256 + lane * 4);
      }
    }
    float s = 0.f;
#pragma unroll
    for (int i = 0; i < 4; ++i) s += (v[i][0] + v[i][1]) + (v[i][2] + v[i][3]);
#pragma unroll
    for (int o = 32; o > 0; o >>= 1) s += __shfl_xor(s, o);
    const float mu = s * (1.f / D);
    float q = 0.f;
#pragma unroll
    for (int i = 0; i < 4; ++i)
#pragma unroll
      for (int j = 0; j < 4; ++j) { const float d = v[i][j] - mu; q += d * d; }
#pragma unroll
    for (int o = 32; o > 0; o >>= 1) q += __shfl_xor(q, o);
    const float rstd = 1.0f / sqrtf(q * (1.f / D) + LN_EPS);
    float* po = nullptr;
    if (last) {
      if (row < TPR) { const int b = row / LP, pos = row - b * LP; if (pos >= 16) po = p.out + O_YP + ((size_t)b * 2048 + pos - 16) * D; }
      else po = p.out + O_YS + (size_t)(row - TPR) * D;
    }
#pragma unroll
    for (int i = 0; i < 4; ++i) {
      f32x4 y;
#pragma unroll
      for (int j = 0; j < 4; ++j) y[j] = (v[i][j] - mu) * rstd * gv[i][j] + bv[i][j];
      *(f32x4*)(px + i * 256 + lane * 4) = y;
      u32x2 w; w[0] = pack2(y[0], y[1]); w[1] = pack2(y[2], y[3]);
      *(u32x2*)(p.Xb + (size_t)row * D + i * 256 + lane * 4) = w;
      if (po) *(f32x4*)(po + i * 256 + lane * 4) = y;
    }
  }
}

constexpr int VT_STRIDE = 164;
constexpr int SM_K = 0, SM_VT = 2 * 160 * 128, SM_BIAS = SM_VT + 2 * 64 * VT_STRIDE * 2;
constexpr int N_ATT_P = NB * 65, N_ATT_S = SB, N_CONV = T / 64;

DI void attn_item(const Params& p, int l, int item, char* smem, const int tid) {
  const int lane = tid & 63, wave = tid >> 6, r = lane & 31, h = lane >> 5;
  const bool samp = item >= N_ATT_P;
  int b, q0, seqlen;
  if (!samp) { b = item / 65; q0 = (item - b * 65) * 32; seqlen = LP; }
  else { b = item - N_ATT_P; q0 = 128; seqlen = 132; }
  const int rowbase = samp ? (TPR + b * 4 - 128) : b * LP;
  const float* sBias = (const float*)(smem + SM_BIAS);
#pragma unroll 1
  for (int idx = tid; idx < 2 * 160 * 8; idx += NT) {
    const int kvh = idx / 1280, rem = idx - kvh * 1280;
    const int j = rem >> 3, c = rem & 7; const int pos = q0 - 128 + j;
    u32x4 kv = {0u, 0u, 0u, 0u}, vv = {0u, 0u, 0u, 0u};
    if (pos >= 0 && pos < seqlen) {
      if (samp && pos < 128) {
        const size_t o = (((size_t)(l * SB + b) * 128 + pos) * 2 + kvh) * 64 + c * 8;
        const f32x4 k0 = *(const f32x4*)(p.cache_k + o), k1 = *(const f32x4*)(p.cache_k + o + 4);
        const f32x4 v0 = *(const f32x4*)(p.cache_v + o), v1 = *(const f32x4*)(p.cache_v + o + 4);
        kv[0] = pack2(k0[0], k0[1]); kv[1] = pack2(k0[2], k0[3]); kv[2] = pack2(k1[0], k1[1]); kv[3] = pack2(k1[2], k1[3]);
        vv[0] = pack2(v0[0], v0[1]); vv[1] = pack2(v0[2], v0[3]); vv[2] = pack2(v1[0], v1[1]); vv[3] = pack2(v1[2], v1[3]);
      } else {
        const bf16_t* src = p.P + (size_t)(rowbase + pos) * NPQ + 512 + kvh * 64 + c * 8;
        kv = *(const u32x4*)src; vv = *(const u32x4*)(src + 128);
      }
    }
    *(u32x4*)(smem + SM_K + kvh * 20480 + lds_off(j, c)) = kv;
    bf16_t* sVt = (bf16_t*)(smem + SM_VT) + kvh * 64 * VT_STRIDE;
#pragma unroll
    for (int e = 0; e < 4; ++e) {
      sVt[(c * 8 + 2 * e) * VT_STRIDE + j] = (bf16_t)(vv[e] & 0xffffu);
      sVt[(c * 8 + 2 * e + 1) * VT_STRIDE + j] = (bf16_t)(vv[e] >> 16);
    }
  }
  const int head = wave, kvh = wave >> 2;
  const char* sK = smem + SM_K + kvh * 20480; const bf16_t* sVt = (const bf16_t*)(smem + SM_VT) + kvh * 64 * VT_STRIDE;
  const int qpos = min(q0 + r, seqlen - 1);
  const bf16_t* qsrc = p.P + (size_t)(rowbase + qpos) * NPQ + head * 64 + 8 * h;
  bf16x8 qf[4];
#pragma unroll
  for (int s = 0; s < 4; ++s) qf[s] = *(const bf16x8*)(qsrc + 16 * s);
  __syncthreads();
  const float sink = p.sink[l * 8 + head];
  const int jmin = max(0, 128 - q0);
  float m = sink;
  f32x16 acc[5];
#pragma unroll
  for (int kt = 0; kt < 5; ++kt) {
#pragma unroll
    for (int i = 0; i < 16; ++i) acc[kt][i] = 0.f;
#pragma unroll
    for (int s = 0; s < 4; ++s) {
      const bf16x8 kf = *(const bf16x8*)(sK + lds_off(32 * kt + r, 2 * s + h));
      acc[kt] = MFMA32(kf, qf[s], acc[kt]);
    }
    const float* bp = sBias + head * 132 + r + 128 - 32 * kt - 4 * h;
#pragma unroll
    for (int i = 0; i < 16; ++i) {
      const int jo = 8 * (i >> 2) + (i & 3);
      const int j = 32 * kt + 4 * h + jo;
      const int d = r + 128 - j;
      const bool valid = (d >= 0) && (d <= 128) && (j >= jmin);
      const float bias = bp[valid ? -jo : (-jo - d)];
      const float sv = valid ? acc[kt][i] * 0.125f + bias : -INFINITY;
      acc[kt][i] = sv; m = fmaxf(m, sv);
    }
    __builtin_amdgcn_sched_barrier(0);
  }
  m = fmaxf(m, __shfl_xor(m, 32));
  float sum = 0.f;
#pragma unroll
  for (int kt = 0; kt < 5; ++kt)
#pragma unroll
    for (int i = 0; i < 16; ++i) { const float e = __expf(acc[kt][i] - m); acc[kt][i] = e; sum += e; }
  sum += __shfl_xor(sum, 32);
  const float inv = 1.f / (sum + __expf(sink - m));
  f32x16 o[2];
#pragma unroll
  for (int dt = 0; dt < 2; ++dt)
#pragma unroll
    for (int i = 0; i < 16; ++i) o[dt][i] = 0.f;
#pragma unroll
  for (int kt = 0; kt < 5; ++kt)
#pragma unroll
    for (int s2 = 0; s2 < 2; ++s2) {
      u32x4 pw;
#pragma unroll
      for (int e = 0; e < 4; ++e) pw[e] = pack2(acc[kt][8 * s2 + 2 * e], acc[kt][8 * s2 + 2 * e + 1]);
      const bf16x8 pf = __builtin_bit_cast(bf16x8, pw);
#pragma unroll
      for (int dt = 0; dt < 2; ++dt) {
        const bf16_t* vp = sVt + (dt * 32 + r) * VT_STRIDE + 32 * kt + 16 * s2 + 4 * h;
        const s16x4 lo = *(const s16x4*)vp, hi = *(const s16x4*)(vp + 8);
        const bf16x8 vf = __builtin_shufflevector(lo, hi, 0, 1, 2, 3, 4, 5, 6, 7);
        o[dt] = MFMA32(vf, pf, o[dt]);
      }
      __builtin_amdgcn_sched_barrier(0);
    }
  if (q0 + r < seqlen) {
    bf16_t* dst = p.MIX + (size_t)(rowbase + q0 + r) * D + head * 64 + 4 * h;
#pragma unroll
    for (int dt = 0; dt < 2; ++dt)
#pragma unroll
      for (int g = 0; g < 4; ++g) {
        u32x2 v; v[0] = pack2(o[dt][4 * g] * inv, o[dt][4 * g + 1] * inv); v[1] = pack2(o[dt][4 * g + 2] * inv, o[dt][4 * g + 3] * inv);
        *(u32x2*)(dst + dt * 32 + 8 * g) = v;
      }
  }
  __syncthreads();
}

DI void unpack8(const u32x4 v, float* f) {
#pragma unroll
  for (int e = 0; e < 4; ++e) { f[2 * e] = bflo(v[e]); f[2 * e + 1] = bfhi(v[e]); }
}

DI void conv_item(const Params& p, int l, int item, const int tid) {
  const int c = (tid & 63) * 8, rs = tid >> 6;
  const float* cw = p.conv_w + (size_t)l * 3 * 512 + c;
  float w0[8], w1[8], w2[8];
#pragma unroll
  for (int e = 0; e < 8; ++e) { w0[e] = cw[e]; w1[e] = cw[512 + e]; w2[e] = cw[1024 + e]; }
#pragma unroll 2
  for (int i = 0; i < 8; ++i) {
    const int row = item * 64 + rs + 8 * i;
    float u0[8], u1[8], u2[8], bg[8];
    unpack8(*(const u32x4*)(p.U + (size_t)row * 512 + c), u2);
    unpack8(*(const u32x4*)(p.P + (size_t)row * NPQ + 768 + c), bg);
    if (row < TPR) {
      const int pos = row % LP;
      if (pos >= 1) unpack8(*(const u32x4*)(p.U + (size_t)(row - 1) * 512 + c), u1); else { for (int e = 0; e < 8; ++e) u1[e] = 0.f; }
      if (pos >= 2) unpack8(*(const u32x4*)(p.U + (size_t)(row - 2) * 512 + c), u0); else { for (int e = 0; e < 8; ++e) u0[e] = 0.f; }
    } else {
      const int sb = (row - TPR) >> 2, t = (row - TPR) & 3;
      const float* st = p.state_conv + (size_t)(l * SB + sb) * 2 * 512 + c;
      if (t >= 1) unpack8(*(const u32x4*)(p.U + (size_t)(row - 1) * 512 + c), u1); else { for (int e = 0; e < 8; ++e) u1[e] = st[512 + e]; }
      if (t >= 2) unpack8(*(const u32x4*)(p.U + (size_t)(row - 2) * 512 + c), u0); else { for (int e = 0; e < 8; ++e) u0[e] = st[t * 512 + e]; }
    }
    u32x4 ov;
#pragma unroll
    for (int e = 0; e < 4; ++e) {
      const float a = bg[2 * e] * (w0[2 * e] * u0[2 * e] + w1[2 * e] * u1[2 * e] + w2[2 * e] * u2[2 * e]);
      const float bq = bg[2 * e + 1] * (w0[2 * e + 1] * u0[2 * e + 1] + w1[2 * e + 1] * u1[2 * e + 1] + w2[2 * e + 1] * u2[2 * e + 1]);
      ov[e] = pack2(a, bq);
    }
    *(u32x4*)(p.MIX + (size_t)row * D + 512 + c) = ov;
  }
}

DI void mix_phase(const Params& p, int l, char* smem, int bid, int nb, const int tid) {
  float* sBias = (float*)(smem + SM_BIAS);
  for (int i = tid; i < 8 * 129; i += NT) {
    const int hd = i / 129, d = i - hd * 129;
    int bk;
    if (d < 16) bk = d; else { bk = 16 + (int)(log2f((float)d * (1.f / 16.f)) * (16.f / 3.f) + 1e-4f); bk = min(bk, 31); }
    sBias[hd * 132 + d] = p.rel_bias[bk * 8 + hd];
  }
  __syncthreads();
  const int total = N_ATT_P + N_ATT_S + N_CONV;
  for (int it = bid; it < total; it += nb) {
    if (it < N_ATT_P + N_ATT_S) attn_item(p, l, it, smem, tid);
    else conv_item(p, l, it - (N_ATT_P + N_ATT_S), tid);
  }
  __syncthreads();
}

__global__ void __launch_bounds__(512, 2) mk_forward(Params p) {
  extern __shared__ __attribute__((aligned(16))) unsigned char lds[];
  char* smem = (char*)lds;
  const int nb = gridDim.x, bid = blockIdx.x;
  for (int ph = p.phase_lo; ph < p.phase_hi; ++ph) {
    int tid = threadIdx.x; asm volatile("" : "+v"(tid));
    if (ph == 0) { if (!(DISABLE & 1)) prep_phase(p, bid, nb, tid); }
    else {
      const int l = (ph - 1) / 10, s = (ph - 1) % 10;
      switch (s) {
        case 0: case 7: if (!(DISABLE & 2)) {
          const int f = s == 0 ? 0 : 1;
          EpiGU e{p.H};
          run_gemm(lds, p.Xb, p.Wgu + (size_t)(l * 2 + f) * 2 * DFF * D, 2 * DFF, D, e, tid);
        } break;
        case 1: case 8: if (!(DISABLE & 4)) {
          const int f = s == 1 ? 0 : 1;
          EpiRes e{p.Xf, p.Part, 0.5f};
          run_gemm_split(lds, p.H, p.Wd + (size_t)(l * 2 + f) * D * DFF, D, DFF, 11, e, tid);
        } break;
        case 2: if (!(DISABLE & 8)) ln_phase(p, l * 3 + 0, false, 11, bid, nb, tid); break;
        case 6: if (!(DISABLE & 8)) ln_phase(p, l * 3 + 1, false, 4, bid, nb, tid); break;
        case 9: if (!(DISABLE & 8)) ln_phase(p, l * 3 + 2, l == DEPTH - 1, 11, bid, nb, tid); break;
        case 3: if (!(DISABLE & 16)) {
          EpiIn e{p.P, p.U, p.out, l};
          run_gemm(lds, p.Xb, p.Win + (size_t)l * DIN * D, DIN, D, e, tid);
        } break;
        case 4: if (!(DISABLE & 32)) mix_phase(p, l, smem, bid, nb, tid); break;
        case 5: if (!(DISABLE & 64)) {
          EpiRes e{p.Xf, p.Part, 1.0f};
          run_gemm_split(lds, p.MIX, p.Wout + (size_t)l * D * D, D, D, 4, e, tid);
        } break;
      }
    }
    if (ph + 1 < p.phase_hi) cg::this_grid().sync();
  }
}

extern "C" void kernel_launch(void* const* d_in, const int* in_sizes, int n_in, void* d_out, int out_size, void* d_ws, size_t ws_size, hipStream_t stream) {
  static int grid_blocks = 0;
  if (!grid_blocks) {
    int dev = 0, cus = 0, per_cu = 0;
    (void)hipGetDevice(&dev);
    (void)hipDeviceGetAttribute(&cus, hipDeviceAttributeMultiprocessorCount, dev);
    if (hipFuncSetAttribute((const void*)mk_forward, hipFuncAttributeMaxDynamicSharedMemorySize, LDS_BYTES) != hipSuccess) fprintf(stderr, "hipFuncSetAttribute failed\n");
    (void)hipOccupancyMaxActiveBlocksPerMultiprocessor(&per_cu, mk_forward, NT, LDS_BYTES);
    if (per_cu < 1) fprintf(stderr, "occupancy query says %d blocks per CU\n", per_cu);
    grid_blocks = 256;
    if (cus != 256) fprintf(stderr, "expected 256 CUs, found %d\n", cus);
  }
  Params p{};
  p.x_prompt = (const float*)d_in[0]; p.x_sample = (const float*)d_in[1]; p.cache_k = (const float*)d_in[2]; p.cache_v = (const float*)d_in[3];
  p.state_conv = (const float*)d_in[4]; p.meta = (const float*)d_in[5]; p.rel_bias = (const float*)d_in[6]; p.w_in = (const float*)d_in[7];
  p.conv_w = (const float*)d_in[8]; p.sink = (const float*)d_in[9]; p.w_out = (const float*)d_in[10]; p.w_gate = (const float*)d_in[11];
  p.w_up = (const float*)d_in[12]; p.w_down = (const float*)d_in[13]; p.ln_g = (const float*)d_in[14]; p.ln_b = (const float*)d_in[15];
  p.out = (float*)d_out;
  char* w = (char*)d_ws; size_t off = 0;
  auto take = [&](size_t bytes) { char* q = w + off; off += (bytes + 255) & ~(size_t)255; return q; };
  p.Wgu = (bf16_t*)take((size_t)DEPTH * 2 * 2 * DFF * D * 2);
  p.Wd = (bf16_t*)take((size_t)DEPTH * 2 * D * DFF * 2);
  p.Win = (bf16_t*)take((size_t)DEPTH * DIN * D * 2);
  p.Wout = (bf16_t*)take((size_t)DEPTH * D * D * 2);
  p.Xf = (float*)take((size_t)TPAD * D * 4);
  p.Part = (float*)take((size_t)11 * SPLIT_ROWS * D * 4);
  p.Xb = (bf16_t*)take((size_t)TPAD * D * 2);
  p.H = (bf16_t*)take((size_t)TPAD * DFF * 2);
  p.P = p.H; p.U = p.P + (size_t)T * NPQ; p.MIX = p.U + (size_t)T * 512;
  const int NPH = 1 + 10 * DEPTH;
#if MK_MULTI
  for (int ph = 0; ph < NPH; ++ph) {
    p.phase_lo = ph; p.phase_hi = ph + 1;
    hipLaunchKernelGGL(mk_forward, dim3(grid_blocks), dim3(NT), LDS_BYTES, stream, p);
  }
#else
  p.phase_lo = 0; p.phase_hi = NPH;
  void* args[] = {&p};
  hipError_t e = hipLaunchCooperativeKernel((void*)mk_forward, dim3(grid_blocks), dim3(NT), args, LDS_BYTES, stream);
  if (e != hipSuccess) fprintf(stderr, "cooperative launch failed: %s (grid %d)\n", hipGetErrorString(e), grid_blocks);
#endif
}
```

```cpp
#include <hip/hip_runtime.h>
#include <hip/hip_cooperative_groups.h>
#include <cstdio>
namespace cg = cooperative_groups;

#ifndef MK_MULTI
#define MK_MULTI 0
#endif
#ifndef DISABLE
#define DISABLE 0
#endif
#ifndef PROBE
#define PROBE 0
#endif
#define DI __device__ __forceinline__
namespace pg8 {
#define PG8_LAS __attribute__((address_space(3)))
typedef unsigned short bf16_t;
typedef short bf16x8 __attribute__((ext_vector_type(8)));
typedef float f32x4 __attribute__((ext_vector_type(4)));
typedef unsigned u32x4 __attribute__((ext_vector_type(4)));
constexpr int BM = 256, BK = 64, HALF = 128, HTB = HALF * BK * 2  , STAGE_BYTES = 8 * HTB, NXCD = 8, WGM = 8;

__host__ __device__ __forceinline__ int lds_byte(int r, int c) { const int st = (r >> 4) * 2 + (c >> 5), rr = r & 15, cc = c & 31, ob = rr * 64 + cc * 2; return st * 1024 + (ob ^ (((ob >> 9) & 1) << 5)); }
__host__ __device__ __forceinline__ void stage_rc(int b, int& R, int& C) { const int st = b / 1024, sb = b % 1024, swz = sb ^ (((sb >> 9) & 1) << 5); R = (st >> 1) * 16 + swz / 64; C = (st & 1) * 32 + (swz % 64) / 2; }
__host__ __device__ __forceinline__ int perm32(int rho) { const int n = rho >> 4, i = rho & 15; return 8 * (i >> 2) + 4 * n + (i & 3); }

struct Unit { int pm, pn, kt0, nt, split; };
struct Gemm { const bf16_t* A; const bf16_t* Bt; int M, N, K; };

struct StaticOrder {
    int nM, nN, nwg, G, c, ntk;
    __host__ __device__ void init(int M, int N, int K, int G_, int c_) { nM = M / BM; nN = N / BM; nwg = nM * nN; G = G_; c = c_; ntk = K / BK; }
    __host__ __device__ bool next(int i, Unit& u) const {
        const long L = (long)i * G + c; if (L >= nwg) return false;
        int wgid = (int)L; { const int q = nwg / NXCD, r = nwg % NXCD, xcd = wgid % NXCD, off = wgid / NXCD; wgid = (xcd < r ? xcd * (q + 1) : r * (q + 1) + (xcd - r) * q) + off; }
        const int nig = WGM * nN, gid = wgid / nig, fm = gid * WGM, gsz = (nM - fm) < WGM ? (nM - fm) : WGM;
        u.pm = fm + ((wgid % nig) % gsz); u.pn = (wgid % nig) / gsz; u.kt0 = 0; u.nt = ntk; u.split = 0; return true;
    }
    __device__ __forceinline__ void a_ready(const Unit&) const {}
    __device__ __forceinline__ void done(const Unit&) const {}
};

template <class Epi, class Sched, bool STAMP = false>
__device__ __forceinline__ void gemm_phase(PG8_LAS unsigned char* lds, const Gemm g, const Sched& S, const Epi& E, unsigned long long* stamps, const int tid) {
    const int wid = __builtin_amdgcn_readfirstlane(tid >> 6), lane = tid & 63, wr = wid >> 2, wc = wid & 3, fr = lane & 15, fq = lane >> 4;
    const int K = g.K;
    int ts_lo = 0, ts_hi = 0, nts = 0; const unsigned long long rt_entry = STAMP ? (unsigned long long)wall_clock64() : 0ull;
#define PG8_STAMP() do { if (STAMP && wid == 0 && nts < 64) { const unsigned long long _c = (unsigned long long)clock64(); \
        ts_lo = (lane == nts) ? (int)(unsigned)_c : ts_lo; ts_hi = (lane == nts) ? (int)(unsigned)(_c >> 32) : ts_hi; ++nts; } } while (0)
    PG8_STAMP();
    unsigned voffA[2], voffB[2];
#pragma unroll
    for (int i = 0; i < 2; ++i) { int R, C; stage_rc(tid * 16 + i * 8192, R, C); const int Rb = Epi::PERM ? ((R & ~31) + perm32(R & 31)) : R;
        voffA[i] = (unsigned)(R * K + C) * 2u; voffB[i] = (unsigned)(Rb * K + C) * 2u; }
    const size_t kstep = (size_t)(BK * 2);
    const size_t hstep = (size_t)HALF * K * 2;
    const size_t tstep = 2 * hstep;
    const unsigned ldsw = (unsigned)wid * 1024u;
    const int aoff = lds_byte(wr * 64 + fr, fq * 8), boff = lds_byte(wc * 32 + fr, fq * 8);
#define PG8_SA(b, h) (((b) * 2 + (h)) * HTB)
#define PG8_SB(b, h) ((4 + (b) * 2 + (h)) * HTB)
#define PG8_STAGE(bufoff, gbase, voff) do { _Pragma("unroll") for (int _i = 0; _i < 2; ++_i) \
        __builtin_amdgcn_global_load_lds((const unsigned*)((const char*)(gbase) + (voff)[_i]), (PG8_LAS unsigned*)(lds + (bufoff) + ldsw + _i * 8192), 16, 0, 0); } while (0)
#define PG8_LDA(dst, b, h) do { _Pragma("unroll") for (int m = 0; m < 4; ++m) _Pragma("unroll") for (int k = 0; k < 2; ++k) dst[m][k] = *(const PG8_LAS bf16x8*)(lds + PG8_SA(b, h) + aoff + m * 2048 + k * 1024); } while (0)
#define PG8_LDB(dst, b, h) do { _Pragma("unroll") for (int n = 0; n < 2; ++n) _Pragma("unroll") for (int k = 0; k < 2; ++k) dst[n][k] = *(const PG8_LAS bf16x8*)(lds + PG8_SB(b, h) + boff + n * 2048 + k * 1024); } while (0)
#define PG8_MMA(ai, bj, At, Bt) do { __builtin_amdgcn_s_setprio(1); _Pragma("unroll") for (int m = 0; m < 4; ++m) _Pragma("unroll") for (int n = 0; n < 2; ++n) _Pragma("unroll") for (int k = 0; k < 2; ++k) \
        acc[ai][bj][m][n] = __builtin_amdgcn_mfma_f32_16x16x32_bf16(Bt[n][k], At[m][k], acc[ai][bj][m][n], 0, 0, 0); __builtin_amdgcn_s_setprio(0); } while (0)
#define PG8_WAIT_V(n) asm volatile("s_waitcnt vmcnt(" #n ")" ::: "memory")
#define PG8_WAIT_L(n) asm volatile("s_waitcnt lgkmcnt(" #n ")" ::: "memory")
#define PG8_BAR __builtin_amdgcn_s_barrier()
#define PG8_SCHED __builtin_amdgcn_sched_barrier(0)
    Unit cur, nxt; int ui = 0;
    if (!S.next(0, cur)) return;
    f32x4 acc[2][2][4][2];
#pragma unroll
    for (int a = 0; a < 2; ++a)
#pragma unroll
        for (int b = 0; b < 2; ++b)
#pragma unroll
            for (int m = 0; m < 4; ++m)
#pragma unroll
                for (int n = 0; n < 2; ++n) acc[a][b][m][n] = (f32x4){0.f, 0.f, 0.f, 0.f};
    bf16x8 At[4][2], B0[2][2], B1[2][2];
    const char* cA = (const char*)g.A + (size_t)cur.pm * tstep + (size_t)cur.kt0 * kstep; const char* cB = (const char*)g.Bt + (size_t)cur.pn * tstep + (size_t)cur.kt0 * kstep;
    S.a_ready(cur);
    PG8_STAGE(PG8_SB(0, 0), cB, voffB); PG8_STAGE(PG8_SA(0, 0), cA, voffA); PG8_STAGE(PG8_SB(0, 1), cB + hstep, voffB); PG8_STAGE(PG8_SA(0, 1), cA + hstep, voffA);
    if (wr == 1) PG8_BAR;
    PG8_WAIT_V(4); PG8_BAR;
    PG8_STAGE(PG8_SB(1, 0), cB + kstep, voffB); PG8_STAGE(PG8_SA(1, 0), cA + kstep, voffA); PG8_STAGE(PG8_SB(1, 1), cB + hstep + kstep, voffB);
    PG8_WAIT_V(6); PG8_BAR;
    PG8_STAMP();
    for (;;) {
        const bool has_next = S.next(ui + 1, nxt);
        const char* nA = has_next ? (const char*)g.A + (size_t)nxt.pm * tstep + (size_t)nxt.kt0 * kstep : cA; const char* nB = has_next ? (const char*)g.Bt + (size_t)nxt.pn * tstep + (size_t)nxt.kt0 * kstep : cB;
        const int nt = cur.nt;
        for (int t = 0; t < nt; t += 2) {
            const bool last = (t == nt - 2);
            const char* a1 = cA + (size_t)(t + 1) * kstep;
            const char* a2 = last ? nA : cA + (size_t)(t + 2) * kstep; const char* b2 = last ? nB : cB + (size_t)(t + 2) * kstep;
            const char* a3 = a2 + kstep; const char* b3 = b2 + kstep;
            if (last && has_next) S.a_ready(nxt);
            PG8_LDB(B0, 0, 0); PG8_SCHED; PG8_LDA(At, 0, 0); PG8_STAGE(PG8_SA(1, 1), a1 + hstep, voffA);
            PG8_WAIT_L(8); PG8_BAR; PG8_WAIT_L(0); PG8_MMA(0, 0, At, B0); PG8_BAR; PG8_SCHED;
            PG8_LDB(B1, 0, 1); PG8_STAGE(PG8_SB(0, 0), b2, voffB);
            PG8_BAR; PG8_WAIT_L(0); PG8_MMA(0, 1, At, B1); PG8_BAR;
            PG8_LDA(At, 0, 1); PG8_STAGE(PG8_SA(0, 0), a2, voffA);
            PG8_BAR; PG8_WAIT_L(0); PG8_MMA(1, 0, At, B0); PG8_BAR; PG8_SCHED;
            PG8_STAGE(PG8_SB(0, 1), b2 + hstep, voffB);
            PG8_WAIT_V(6); PG8_BAR; PG8_MMA(1, 1, At, B1); PG8_BAR;
            PG8_LDB(B0, 1, 0); PG8_SCHED; PG8_LDA(At, 1, 0); PG8_STAGE(PG8_SA(0, 1), a2 + hstep, voffA);
            PG8_WAIT_L(8); PG8_BAR; PG8_WAIT_L(0); PG8_MMA(0, 0, At, B0); PG8_BAR; PG8_SCHED;
            PG8_LDB(B1, 1, 1); PG8_STAGE(PG8_SB(1, 0), b3, voffB);
            PG8_BAR; PG8_WAIT_L(0); PG8_MMA(0, 1, At, B1); PG8_BAR;
            PG8_LDA(At, 1, 1); PG8_STAGE(PG8_SA(1, 0), a3, voffA);
            PG8_BAR; PG8_WAIT_L(0); PG8_MMA(1, 0, At, B0); PG8_BAR; PG8_SCHED;
            PG8_STAGE(PG8_SB(1, 1), b3 + hstep, voffB);
            PG8_WAIT_V(6); PG8_BAR; PG8_MMA(1, 1, At, B1); PG8_BAR;
        }
        PG8_STAMP();
        if constexpr (!Epi::AFTER_DRAIN) { E(acc, cur, wr, wc, fr, fq); S.done(cur); }
        PG8_STAMP();
        if (!has_next) break;
#pragma unroll
        for (int a = 0; a < 2; ++a)
#pragma unroll
            for (int b = 0; b < 2; ++b)
#pragma unroll
                for (int m = 0; m < 4; ++m)
#pragma unroll
                    for (int n = 0; n < 2; ++n) acc[a][b][m][n] = (f32x4){0.f, 0.f, 0.f, 0.f};
        cur = nxt; cA = nA; cB = nB; ++ui;
    }
    PG8_WAIT_V(0);
    if (wr == 0) PG8_BAR;
    PG8_BAR;
    if constexpr (Epi::AFTER_DRAIN) { E.fused(acc, cur, wr, wc, fr, fq, lds, wid, lane); S.done(cur); }
    PG8_STAMP();
    if (STAMP && wid == 0) { stamps[lane] = lane < nts ? (((unsigned long long)(unsigned)ts_hi << 32) | (unsigned)ts_lo) : 0ull;
        if (lane == 62) stamps[62] = rt_entry; if (lane == 63) stamps[63] = (unsigned long long)wall_clock64(); }
#undef PG8_STAMP
#undef PG8_SA
#undef PG8_SB
#undef PG8_STAGE
#undef PG8_LDA
#undef PG8_LDB
#undef PG8_MMA
#undef PG8_WAIT_V
#undef PG8_WAIT_L
#undef PG8_BAR
#undef PG8_SCHED
}
}


using pg8::bf16_t; using pg8::bf16x8; using pg8::f32x4; using pg8::u32x4;
typedef short s16x4 __attribute__((ext_vector_type(4)));
typedef float f32x16 __attribute__((ext_vector_type(16)));
typedef unsigned u32x2 __attribute__((ext_vector_type(2)));

constexpr int D = 1024, DFF = 2816, DEPTH = 4;
constexpr int LP = 2064, NB = 8, TPR = NB * LP;
constexpr int SB = 128, ST = 4, TSR = SB * ST;
constexpr int T = TPR + TSR;
constexpr int TPAD = 17152;
constexpr int NPQ = 1280;
constexpr int DIN = 2304;
constexpr float ALPHA = 1.681792830507429f;
constexpr float LN_EPS = 1e-5f;
constexpr int LDS_BYTES = 131072 + 16;
constexpr int NT = 512;
constexpr int SPLIT_ROW0 = 16384, SPLIT_ROWS = 768;

struct Params {
  const float* x_prompt; const float* x_sample; const float* cache_k; const float* cache_v; const float* state_conv;
  const float* meta; const float* rel_bias; const float* w_in; const float* conv_w; const float* sink;
  const float* w_out; const float* w_gate; const float* w_up; const float* w_down; const float* ln_g; const float* ln_b;
  float* out; unsigned* bar;
  bf16_t* Wgu; bf16_t* Wd; bf16_t* Win; bf16_t* Wout;
  float* Xf; float* Part; bf16_t* Xb; bf16_t* H; bf16_t* P; bf16_t* U; bf16_t* MIX;
  int phase_lo, phase_hi;
};

constexpr size_t O_YP = 0;
constexpr size_t O_YS = O_YP + (size_t)8 * 2048 * 1024;
constexpr size_t O_KP = O_YS + (size_t)512 * 1024;
constexpr size_t O_VP = O_KP + (size_t)4 * 8 * 128 * 128;
constexpr size_t O_CP = O_VP + (size_t)4 * 8 * 128 * 128;
constexpr size_t O_KS = O_CP + (size_t)4 * 8 * 2 * 512;
constexpr size_t O_VS = O_KS + (size_t)4 * 128 * 128 * 128;
constexpr size_t O_CS = O_VS + (size_t)4 * 128 * 128 * 128;

DI unsigned f2bf(float x) { unsigned u = __float_as_uint(x); u += 0x7fffu + ((u >> 16) & 1u); return u >> 16; }
typedef __bf16 bf16x2_t __attribute__((ext_vector_type(2)));
typedef float f32x2_t __attribute__((ext_vector_type(2)));
DI unsigned pack2(float lo, float hi) { f32x2_t f = {lo, hi}; bf16x2_t v = __builtin_convertvector(f, bf16x2_t); return __builtin_bit_cast(unsigned, v); }
DI float bflo(unsigned v) { return __uint_as_float(v << 16); }
DI float bfhi(unsigned v) { return __uint_as_float(v & 0xffff0000u); }

#define MFMA32(a, b, c) __builtin_amdgcn_mfma_f32_32x32x16_bf16((a), (b), (c), 0, 0, 0)

DI int lds_off(int row, int chunk) { return row * 128 + ((chunk ^ ((row >> 1) & 7)) << 4); }

#define XB_TMO      128
#define XB_XCNT(j)  (256  + 64 * (j))
#define XB_XSUB(j)  (1280 + 64 * (j))
#define XB_XGEN(j)  (2304 + 64 * (j))
#define XB_TOP      3328
#define XB_TOPGEN   3392
#define XCD_BAR_WORDS 3456
#define XB_SPIN_CAP (1u << 18)
#define LAS __attribute__((address_space(3)))

__device__ __forceinline__ unsigned xb_ld(unsigned* p)              { return __hip_atomic_load(p, __ATOMIC_RELAXED, __HIP_MEMORY_SCOPE_AGENT); }
__device__ __forceinline__ unsigned xb_add(unsigned* p, unsigned v) { return __hip_atomic_fetch_add(p, v, __ATOMIC_RELAXED, __HIP_MEMORY_SCOPE_AGENT); }
__device__ __forceinline__ unsigned xb_xcc_id() { return (unsigned)__builtin_amdgcn_s_getreg((3 << 11) | 20) & 0xFu; }
#define XB_SPIN(cond, bar) do { unsigned _sp = 0; while (cond) { __builtin_amdgcn_s_sleep(1); \
    if ((++_sp & 255u) == 0u) { if (xb_ld(&(bar)[XB_TMO])) break; if (_sp > XB_SPIN_CAP) { atomicAdd(&(bar)[XB_TMO], 1u); break; } } } } while (0)

struct XcdBarrier {
    unsigned* bar; unsigned x;
    volatile LAS unsigned* st;
};

__device__ __forceinline__ XcdBarrier xcd_barrier_post(unsigned* bar, volatile LAS unsigned* st) {
    XcdBarrier b; b.bar = bar; b.x = xb_xcc_id(); b.st = st;
    if (threadIdx.x == 0) (void)xb_add(&bar[XB_XCNT(b.x)], 1u);
    return b;
}
__device__ __forceinline__ void xcd_barrier_complete(unsigned* bar, unsigned x, unsigned& nloc, unsigned& nx) {
    const unsigned G = gridDim.x * gridDim.y * gridDim.z;
    unsigned sum, cnt, mine, sp = 0u;
    for (;;) {
        sum = 0u; cnt = 0u; mine = 0u;
#pragma unroll
        for (unsigned j = 0; j < 16; ++j) { const unsigned c = xb_ld(&bar[XB_XCNT(j)]); sum += c; cnt += (c > 0u) ? 1u : 0u; mine = (j == x) ? c : mine; }
        if (sum == G) break;
        __builtin_amdgcn_s_sleep(1);
        if ((++sp & 255u) == 0u) { if (xb_ld(&bar[XB_TMO])) break; if (sp > XB_SPIN_CAP) { atomicAdd(&bar[XB_TMO], 1u); break; } }
    }
    nloc = mine > 0u ? mine : 1u; nx = cnt > 0u ? cnt : 1u;
}

__device__ __forceinline__ void xcd_barrier(const XcdBarrier& b) {
    asm volatile("s_waitcnt vmcnt(0)" ::: "memory");
    __syncthreads();
    if (threadIdx.x == 0) {
        unsigned* bar = b.bar;
        __builtin_amdgcn_s_waitcnt(0);
        unsigned nloc = b.st[0], nx = b.st[1];
        if (nloc == 0u) { xcd_barrier_complete(bar, b.x, nloc, nx); b.st[0] = nloc; b.st[1] = nx; }
        const unsigned old = xb_add(&bar[XB_XSUB(b.x)], 1u);
        const unsigned gen = old / nloc;
        if (old + 1u == (gen + 1u) * nloc) {
            __builtin_amdgcn_fence(__ATOMIC_RELEASE, "agent");
            asm volatile("s_waitcnt vmcnt(0)" ::: "memory");
            const unsigned og = xb_add(&bar[XB_TOP], 1u);
            const unsigned tg = og / nx;
            if (og + 1u == (tg + 1u) * nx) xb_add(&bar[XB_TOPGEN], 1u);
            else XB_SPIN(xb_ld(&bar[XB_TOPGEN]) == tg, bar);
            __builtin_amdgcn_fence(__ATOMIC_ACQUIRE, "agent");
            xb_add(&bar[XB_XGEN(b.x)], 1u);
            asm volatile("s_waitcnt vmcnt(0)" ::: "memory");
        } else {
            XB_SPIN(xb_ld(&bar[XB_XGEN(b.x)]) == gen, bar);
            __builtin_amdgcn_fence(__ATOMIC_ACQUIRE, "agent");
            asm volatile("s_waitcnt vmcnt(0)" ::: "memory");
        }
    }
    __syncthreads();
}


struct EpiGU {
  static constexpr bool PERM = true, AFTER_DRAIN = false;
  bf16_t* H;
  DI void operator()(const f32x4 (&acc)[2][2][4][2], const pg8::Unit& u, int wr, int wc, int fr, int fq) const {
    const int row0 = u.pm * 256 + wr * 64 + fr, col0 = u.pn * 128 + wc * 32 + 8 * fq;
#pragma unroll
    for (int ai = 0; ai < 2; ++ai)
#pragma unroll
      for (int m = 0; m < 4; ++m) {
        const int row = row0 + ai * 128 + m * 16;
        if (row < T) {
          float o[8];
#pragma unroll
          for (int n = 0; n < 2; ++n)
#pragma unroll
            for (int j = 0; j < 4; ++j) { const float ga = acc[ai][0][m][n][j], up = acc[ai][1][m][n][j]; o[4 * n + j] = ga * up * __builtin_amdgcn_rcpf(1.f + __expf(-ga)); }
          u32x4 w; w[0] = pack2(o[0], o[1]); w[1] = pack2(o[2], o[3]); w[2] = pack2(o[4], o[5]); w[3] = pack2(o[6], o[7]);
          *(u32x4*)(H + (size_t)row * DFF + col0) = w;
        }
      }
  }
};
struct EpiRes {
  static constexpr bool PERM = false, AFTER_DRAIN = false;
  float* X; float* Part; float scale;
  DI void operator()(const f32x4 (&acc)[2][2][4][2], const pg8::Unit& u, int wr, int wc, int fr, int fq) const {
    const int row0 = u.pm * 256 + wr * 64 + fr, col0 = u.pn * 256 + wc * 32 + 4 * fq;
#pragma unroll
    for (int ai = 0; ai < 2; ++ai)
#pragma unroll
      for (int m = 0; m < 4; ++m) {
        const int row = row0 + ai * 128 + m * 16;
        if (row < T) {
          if (!u.split) {
            float* px = X + (size_t)row * D + col0;
#pragma unroll
            for (int bj = 0; bj < 2; ++bj)
#pragma unroll
              for (int n = 0; n < 2; ++n) {
                f32x4 x = *(const f32x4*)(px + bj * 128 + n * 16);
#pragma unroll
                for (int j = 0; j < 4; ++j) x[j] = ALPHA * x[j] + scale * acc[ai][bj][m][n][j];
                *(f32x4*)(px + bj * 128 + n * 16) = x;
              }
          } else {
            float* pp = Part + ((size_t)(u.split - 1) * SPLIT_ROWS + (row - SPLIT_ROW0)) * D + col0;
#pragma unroll
            for (int bj = 0; bj < 2; ++bj)
#pragma unroll
              for (int n = 0; n < 2; ++n) *(f32x4*)(pp + bj * 128 + n * 16) = acc[ai][bj][m][n] * scale;
          }
        }
      }
  }
};
struct EpiIn {
  static constexpr bool PERM = true, AFTER_DRAIN = false;
  bf16_t* P; bf16_t* U; float* out; int l;
  DI void operator()(const f32x4 (&acc)[2][2][4][2], const pg8::Unit& u, int wr, int wc, int fr, int fq) const {
    const int row0 = u.pm * 256 + wr * 64 + fr, cl = wc * 32 + 8 * fq;
#pragma unroll
    for (int ai = 0; ai < 2; ++ai)
#pragma unroll
      for (int m = 0; m < 4; ++m) {
        const int row = row0 + ai * 128 + m * 16;
        if (row >= T) continue;
        int b, pos; const bool samp = row >= TPR;
        if (!samp) { b = row / LP; pos = row - b * LP; } else { b = (row - TPR) >> 2; pos = (row - TPR) & 3; }
        if (u.pn < 5) {
#pragma unroll
          for (int bj = 0; bj < 2; ++bj) {
            const f32x4 v0 = acc[ai][bj][m][0], v1 = acc[ai][bj][m][1];
            u32x4 w; w[0] = pack2(v0[0], v0[1]); w[1] = pack2(v0[2], v0[3]); w[2] = pack2(v1[0], v1[1]); w[3] = pack2(v1[2], v1[3]);
            *(u32x4*)(P + (size_t)row * NPQ + u.pn * 256 + bj * 128 + cl) = w;
            if (u.pn == 2) {
              float* so = nullptr;
              if (!samp) { if (pos >= LP - 128) so = out + (bj ? O_VP : O_KP) + ((size_t)(l * NB + b) * 128 + (pos - (LP - 128))) * 128; }
              else so = out + (bj ? O_VS : O_KS) + ((size_t)(l * SB + b) * 128 + 124 + pos) * 128;
              if (so) { *(f32x4*)(so + cl) = v0; *(f32x4*)(so + cl + 4) = v1; }
            }
          }
        } else {
          f32x4 f0, f1;
#pragma unroll
          for (int j = 0; j < 4; ++j) { f0[j] = acc[ai][0][m][0][j] * acc[ai][1][m][0][j]; f1[j] = acc[ai][0][m][1][j] * acc[ai][1][m][1][j]; }
          const int c0 = (u.pn - 5) * 128 + cl;
          u32x4 w; w[0] = pack2(f0[0], f0[1]); w[1] = pack2(f0[2], f0[3]); w[2] = pack2(f1[0], f1[1]); w[3] = pack2(f1[2], f1[3]);
          *(u32x4*)(U + (size_t)row * 512 + c0) = w;
          float* so = nullptr;
          if (!samp) { if (pos >= LP - 2) so = out + O_CP + ((size_t)(l * NB + b) * 2 + (pos - (LP - 2))) * 512; }
          else if (pos >= 2) so = out + O_CS + ((size_t)(l * SB + b) * 2 + (pos - 2)) * 512;
          if (so) { *(f32x4*)(so + c0) = f0; *(f32x4*)(so + c0 + 4) = f1; }
        }
      }
  }
};

template <class Epi>
DI void run_gemm(unsigned char* lds, const bf16_t* A, const bf16_t* Bt, int N, int K, const Epi& e, const int tid) {
  pg8::Gemm g; g.A = A; g.Bt = Bt; g.M = TPAD; g.N = N; g.K = K;
  pg8::StaticOrder S; S.init(TPAD, N, K, (int)gridDim.x, (int)blockIdx.x);
  pg8::gemm_phase<Epi, pg8::StaticOrder, false>((PG8_LAS unsigned char*)lds, g, S, e, nullptr, tid);
}


struct SplitOrder {
  pg8::StaticOrder base; int S, c;
  DI void init(int N, int K, int G, int c_, int S_) { base.init(16384, N, K, G, c_); S = S_; c = c_; }
  DI bool next(int i, pg8::Unit& u) const {
    if (i == 0) return base.next(0, u);
    if (i == 1 && c < 12 * S) { const int j = c / S, sl = c - j * S; u.pm = 64 + (j >> 2); u.pn = j & 3; u.nt = base.ntk / S; u.kt0 = sl * u.nt; u.split = 1 + sl; return true; }
    return false;
  }
  DI void a_ready(const pg8::Unit&) const {}
  DI void done(const pg8::Unit&) const {}
};
template <class Epi>
DI void run_gemm_split(unsigned char* lds, const bf16_t* A, const bf16_t* Bt, int N, int K, int S, const Epi& e, const int tid) {
  pg8::Gemm g; g.A = A; g.Bt = Bt; g.M = TPAD; g.N = N; g.K = K;
  SplitOrder O; O.init(N, K, (int)gridDim.x, (int)blockIdx.x, S);
  pg8::gemm_phase<Epi, SplitOrder, false>((PG8_LAS unsigned char*)lds, g, O, e, nullptr, tid);
}

DI void transpose_unit(const float* __restrict__ src, int ld_src, int c0, int k0, bf16_t* __restrict__ dst, int K, int s0, const int tid) {
  const int lane = tid & 63, wave = tid >> 6;
  const float* s = src + (size_t)(k0 + 32 * wave) * ld_src + c0 + lane;
  bf16_t* d = dst + (size_t)(s0 + lane) * K + k0 + 32 * wave;
  float v[32];
#pragma unroll
  for (int e = 0; e < 32; ++e) v[e] = s[(size_t)e * ld_src];
#pragma unroll
  for (int g = 0; g < 4; ++g) {
    u32x4 w; w[0] = pack2(v[8 * g], v[8 * g + 1]); w[1] = pack2(v[8 * g + 2], v[8 * g + 3]); w[2] = pack2(v[8 * g + 4], v[8 * g + 5]); w[3] = pack2(v[8 * g + 6], v[8 * g + 7]);
    *(u32x4*)(d + 8 * g) = w;
  }
}

DI void prep_phase(const Params& p, int bid, int nb, const int tid) {
  constexpr int U_GU = 88 * 4, U_D = 16 * 11, U_IN = 36 * 4, U_OUT = 16 * 4;
  constexpr int U_L = 2 * U_GU + 2 * U_D + U_IN + U_OUT;
  for (int u = bid; u < DEPTH * U_L; u += nb) {
    const int l = u / U_L; int rem = u - l * U_L;
    if (rem < 2 * U_GU) {
      const int f = rem / U_GU; rem -= f * U_GU; const int sg = rem >> 2, ku = rem & 3;
      const int tile = sg >> 2, q = sg & 3;
      const float* src = ((q >> 1) ? p.w_up : p.w_gate) + (size_t)(l * 2 + f) * D * DFF;
      transpose_unit(src, DFF, tile * 128 + (q & 1) * 64, ku * 256, p.Wgu + (size_t)(l * 2 + f) * 2 * DFF * D, D, sg * 64, tid);
    } else if (rem < 2 * U_GU + 2 * U_D) {
      rem -= 2 * U_GU; const int f = rem / U_D; rem -= f * U_D; const int sg = rem / 11, ku = rem % 11;
      transpose_unit(p.w_down + (size_t)(l * 2 + f) * DFF * D, D, sg * 64, ku * 256, p.Wd + (size_t)(l * 2 + f) * D * DFF, DFF, sg * 64, tid);
    } else if (rem < 2 * U_GU + 2 * U_D + U_IN) {
      rem -= 2 * U_GU + 2 * U_D; const int sg = rem >> 2, ku = rem & 3;
      int c0;
      if (sg < 20) c0 = sg * 64; else { const int g = sg - 20, i = g >> 2, q = g & 3; c0 = ((q >> 1) ? 1792 : 1280) + 128 * i + (q & 1) * 64; }
      transpose_unit(p.w_in + (size_t)l * D * DIN, DIN, c0, ku * 256, p.Win + (size_t)l * DIN * D, D, sg * 64, tid);
    } else {
      rem -= 2 * U_GU + 2 * U_D + U_IN; const int sg = rem >> 2, ku = rem & 3;
      transpose_unit(p.w_out + (size_t)l * D * D, D, sg * 64, ku * 256, p.Wout + (size_t)l * D * D, D, sg * 64, tid);
    }
  }
  const int gt = bid * NT + tid, ngt = nb * NT;
  for (int i = gt; i < T * (D / 4); i += ngt) {
    const int row = i >> 8, c = (i & 255) * 4;
    const float* src;
    if (row < TPR) { const int b = row / LP, pos = row - b * LP; src = pos < 16 ? p.meta + (size_t)pos * D : p.x_prompt + ((size_t)b * 2048 + pos - 16) * D; }
    else src = p.x_sample + (size_t)(row - TPR) * D;
    const f32x4 v = *(const f32x4*)(src + c);
    *(f32x4*)(p.Xf + (size_t)row * D + c) = v;
    u32x2 w; w[0] = pack2(v[0], v[1]); w[1] = pack2(v[2], v[3]);
    *(u32x2*)(p.Xb + (size_t)row * D + c) = w;
  }
  constexpr int PER = 124 * 128 / 4;
  for (int i = gt; i < 2 * DEPTH * SB * PER; i += ngt) {
    const int kv = i / (DEPTH * SB * PER); int rem = i - kv * (DEPTH * SB * PER);
    const int lb = rem / PER; const int e = rem - lb * PER;
    const float* src = (kv ? p.cache_v : p.cache_k) + (size_t)lb * 128 * 128 + 4 * 128 + (size_t)e * 4;
    float* dst = p.out + (kv ? O_VS : O_KS) + (size_t)lb * 128 * 128 + (size_t)e * 4;
    *(f32x4*)dst = *(const f32x4*)src;
  }
}

DI void ln_phase(const Params& p, int lnidx, bool last, int nsplit, int bid, int nb, const int tid) {
  const int lane = tid & 63;
  const int gw = bid * (NT / 64) + (tid >> 6), nw = nb * (NT / 64);
  const float* g = p.ln_g + (size_t)lnidx * D; const float* bb = p.ln_b + (size_t)lnidx * D;
  f32x4 gv[4], bv[4];
#pragma unroll
  for (int i = 0; i < 4; ++i) { gv[i] = *(const f32x4*)(g + i * 256 + lane * 4); bv[i] = *(const f32x4*)(bb + i * 256 + lane * 4); }
  for (int row0 = gw; row0 < T; row0 += 2 * nw) {
    const int rows[2] = {row0, row0 + nw};
    f32x4 v[2][4];
#pragma unroll
    for (int u = 0; u < 2; ++u) {
      const int row = rows[u] < T ? rows[u] : row0;
      const float* px = p.Xf + (size_t)row * D;
#pragma unroll
      for (int i = 0; i < 4; ++i) v[u][i] = *(const f32x4*)(px + i * 256 + lane * 4);
    }
#pragma unroll
    for (int u = 0; u < 2; ++u) {
      const int row = rows[u];
      if (row >= SPLIT_ROW0 && row < T) {
#pragma unroll
        for (int i = 0; i < 4; ++i) v[u][i] *= ALPHA;
        for (int sl = 0; sl < nsplit; ++sl) {
          const float* pp = p.Part + ((size_t)sl * SPLIT_ROWS + (row - SPLIT_ROW0)) * D;
#pragma unroll
          for (int i = 0; i < 4; ++i) v[u][i] += *(const f32x4*)(pp + i * 256 + lane * 4);
        }
      }
    }
    float s[2], q[2];
#pragma unroll
    for (int u = 0; u < 2; ++u) {
      s[u] = 0.f;
#pragma unroll
      for (int i = 0; i < 4; ++i) s[u] += (v[u][i][0] + v[u][i][1]) + (v[u][i][2] + v[u][i][3]);
    }
#pragma unroll
    for (int o = 32; o > 0; o >>= 1) { s[0] += __shfl_xor(s[0], o); s[1] += __shfl_xor(s[1], o); }
#pragma unroll
    for (int u = 0; u < 2; ++u) {
      const float mu = s[u] * (1.f / D);
      q[u] = 0.f;
#pragma unroll
      for (int i = 0; i < 4; ++i)
#pragma unroll
        for (int j = 0; j < 4; ++j) { const float d = v[u][i][j] - mu; q[u] += d * d; }
    }
#pragma unroll
    for (int o = 32; o > 0; o >>= 1) { q[0] += __shfl_xor(q[0], o); q[1] += __shfl_xor(q[1], o); }
#pragma unroll
    for (int u = 0; u < 2; ++u) {
      const int row = rows[u];
      if (row >= T) continue;
      const float mu = s[u] * (1.f / D);
      const float rstd = 1.0f / sqrtf(q[u] * (1.f / D) + LN_EPS);
      float* px = p.Xf + (size_t)row * D;
      float* po = nullptr;
      if (last) {
        if (row < TPR) { const int b = row / LP, pos = row - b * LP; if (pos >= 16) po = p.out + O_YP + ((size_t)b * 2048 + pos - 16) * D; }
        else po = p.out + O_YS + (size_t)(row - TPR) * D;
      }
#pragma unroll
      for (int i = 0; i < 4; ++i) {
        f32x4 y;
#pragma unroll
        for (int j = 0; j < 4; ++j) y[j] = (v[u][i][j] - mu) * rstd * gv[i][j] + bv[i][j];
        *(f32x4*)(px + i * 256 + lane * 4) = y;
        u32x2 w; w[0] = pack2(y[0], y[1]); w[1] = pack2(y[2], y[3]);
        *(u32x2*)(p.Xb + (size_t)row * D + i * 256 + lane * 4) = w;
        if (po) *(f32x4*)(po + i * 256 + lane * 4) = y;
      }
    }
  }
}

constexpr int VT_STRIDE = 164;
constexpr int SM_K = 0, SM_VT = 2 * 160 * 128, SM_BIAS = SM_VT + 2 * 64 * VT_STRIDE * 2;
constexpr int N_ATT_P = NB * 65, N_ATT_S = SB, N_CONV = T / 64;

DI void attn_item(const Params& p, int l, int item, char* smem, const int tid) {
  const int lane = tid & 63, wave = tid >> 6, r = lane & 31, h = lane >> 5;
  const bool samp = item >= N_ATT_P;
  int b, q0, seqlen;
  if (!samp) { b = item / 65; q0 = (item - b * 65) * 32; seqlen = LP; }
  else { b = item - N_ATT_P; q0 = 128; seqlen = 132; }
  const int rowbase = samp ? (TPR + b * 4 - 128) : b * LP;
  const float* sBias = (const float*)(smem + SM_BIAS);
  u32x4 kvr[5], vvr[5];
#pragma unroll
  for (int it = 0; it < 5; ++it) {
    const int idx = tid + it * NT;
    const int kvh = idx / 1280, rem = idx - kvh * 1280;
    const int j = rem >> 3, c = rem & 7; const int pos = q0 - 128 + j;
    u32x4 kv = {0u, 0u, 0u, 0u}, vv = {0u, 0u, 0u, 0u};
    if (pos >= 0 && pos < seqlen) {
      if (samp && pos < 128) {
        const size_t o = (((size_t)(l * SB + b) * 128 + pos) * 2 + kvh) * 64 + c * 8;
        const f32x4 k0 = *(const f32x4*)(p.cache_k + o), k1 = *(const f32x4*)(p.cache_k + o + 4);
        const f32x4 v0 = *(const f32x4*)(p.cache_v + o), v1 = *(const f32x4*)(p.cache_v + o + 4);
        kv[0] = pack2(k0[0], k0[1]); kv[1] = pack2(k0[2], k0[3]); kv[2] = pack2(k1[0], k1[1]); kv[3] = pack2(k1[2], k1[3]);
        vv[0] = pack2(v0[0], v0[1]); vv[1] = pack2(v0[2], v0[3]); vv[2] = pack2(v1[0], v1[1]); vv[3] = pack2(v1[2], v1[3]);
      } else {
        const bf16_t* src = p.P + (size_t)(rowbase + pos) * NPQ + 512 + kvh * 64 + c * 8;
        kv = *(const u32x4*)src; vv = *(const u32x4*)(src + 128);
      }
    }
    kvr[it] = kv; vvr[it] = vv;
  }
#pragma unroll
  for (int it = 0; it < 5; ++it) {
    const int idx = tid + it * NT;
    const int kvh = idx / 1280, rem = idx - kvh * 1280;
    const int j = rem >> 3, c = rem & 7;
    *(u32x4*)(smem + SM_K + kvh * 20480 + lds_off(j, c)) = kvr[it];
    bf16_t* sVt = (bf16_t*)(smem + SM_VT) + kvh * 64 * VT_STRIDE;
#pragma unroll
    for (int e = 0; e < 4; ++e) {
      sVt[(c * 8 + 2 * e) * VT_STRIDE + j] = (bf16_t)(vvr[it][e] & 0xffffu);
      sVt[(c * 8 + 2 * e + 1) * VT_STRIDE + j] = (bf16_t)(vvr[it][e] >> 16);
    }
  }
  const int head = wave, kvh = wave >> 2;
  const char* sK = smem + SM_K + kvh * 20480; const bf16_t* sVt = (const bf16_t*)(smem + SM_VT) + kvh * 64 * VT_STRIDE;
  const int qpos = min(q0 + r, seqlen - 1);
  const bf16_t* qsrc = p.P + (size_t)(rowbase + qpos) * NPQ + head * 64 + 8 * h;
  bf16x8 qf[4];
#pragma unroll
  for (int s = 0; s < 4; ++s) qf[s] = *(const bf16x8*)(qsrc + 16 * s);
  __syncthreads();
  const float sink = p.sink[l * 8 + head];
  auto score_tile = [&](int kt, f32x16& sc, int rr, int hh) {
    const int jlo = max(rr, max(0, 128 - q0)) - 4 * hh, jhi = rr + 128 - 4 * hh;
    const float* bp0 = sBias + head * 132 + rr + 128 - 4 * hh;
#pragma unroll
    for (int i = 0; i < 16; ++i) sc[i] = 0.f;
#pragma unroll
    for (int s = 0; s < 4; ++s) {
      const bf16x8 kf = *(const bf16x8*)(sK + lds_off(32 * kt + rr, 2 * s + hh));
      sc = MFMA32(kf, qf[s], sc);
    }
#pragma unroll
    for (int i = 0; i < 16; ++i) {
      const int jj = 32 * kt + 8 * (i >> 2) + (i & 3);
      const bool valid = (jj >= jlo) && (jj <= jhi);
      const float bias = bp0[-jj];
      sc[i] = valid ? sc[i] * 0.125f + bias : -INFINITY;
    }
  };
  float m = sink;
#pragma unroll
  for (int kt = 0; kt < 5; ++kt) {
    int r1 = r, h1 = h; asm volatile("" : "+v"(r1), "+v"(h1));
    f32x16 sc; score_tile(kt, sc, r1, h1);
#pragma unroll
    for (int i = 0; i < 16; ++i) m = fmaxf(m, sc[i]);
    __builtin_amdgcn_sched_barrier(0);
  }
  m = fmaxf(m, __shfl_xor(m, 32));
  float sum = 0.f;
  f32x16 o[2];
#pragma unroll
  for (int dt = 0; dt < 2; ++dt)
#pragma unroll
    for (int i = 0; i < 16; ++i) o[dt][i] = 0.f;
#pragma unroll
  for (int kt = 0; kt < 5; ++kt) {
    int r2 = r, h2 = h; asm volatile("" : "+v"(r2), "+v"(h2));
    f32x16 sc; score_tile(kt, sc, r2, h2);
#pragma unroll
    for (int i = 0; i < 16; ++i) { sc[i] = __expf(sc[i] - m); sum += sc[i]; }
#pragma unroll
    for (int s2 = 0; s2 < 2; ++s2) {
      u32x4 pw;
#pragma unroll
      for (int e = 0; e < 4; ++e) pw[e] = pack2(sc[8 * s2 + 2 * e], sc[8 * s2 + 2 * e + 1]);
      const bf16x8 pf = __builtin_bit_cast(bf16x8, pw);
#pragma unroll
      for (int dt = 0; dt < 2; ++dt) {
        const bf16_t* vp = sVt + (dt * 32 + r) * VT_STRIDE + 32 * kt + 16 * s2 + 4 * h;
        const s16x4 lo = *(const s16x4*)vp, hi = *(const s16x4*)(vp + 8);
        const bf16x8 vf = __builtin_shufflevector(lo, hi, 0, 1, 2, 3, 4, 5, 6, 7);
        o[dt] = MFMA32(vf, pf, o[dt]);
      }
    }
    __builtin_amdgcn_sched_barrier(0);
  }
  sum += __shfl_xor(sum, 32);
  const float inv = 1.f / (sum + __expf(sink - m));
  if (q0 + r < seqlen) {
    bf16_t* dst = p.MIX + (size_t)(rowbase + q0 + r) * D + head * 64 + 4 * h;
#pragma unroll
    for (int dt = 0; dt < 2; ++dt)
#pragma unroll
      for (int g = 0; g < 4; ++g) {
        u32x2 v; v[0] = pack2(o[dt][4 * g] * inv, o[dt][4 * g + 1] * inv); v[1] = pack2(o[dt][4 * g + 2] * inv, o[dt][4 * g + 3] * inv);
        *(u32x2*)(dst + dt * 32 + 8 * g) = v;
      }
  }
  __syncthreads();
}

DI void unpack8(const u32x4 v, float* f) {
#pragma unroll
  for (int e = 0; e < 4; ++e) { f[2 * e] = bflo(v[e]); f[2 * e + 1] = bfhi(v[e]); }
}

DI void conv_item(const Params& p, int l, int item, const int tid) {
  const int c = (tid & 63) * 8, rs = tid >> 6;
  const float* cw = p.conv_w + (size_t)l * 3 * 512 + c;
  float w0[8], w1[8], w2[8];
#pragma unroll
  for (int e = 0; e < 8; ++e) { w0[e] = cw[e]; w1[e] = cw[512 + e]; w2[e] = cw[1024 + e]; }
#pragma unroll 2
  for (int i = 0; i < 8; ++i) {
    const int row = item * 64 + rs + 8 * i;
    float u0[8], u1[8], u2[8], bg[8];
    unpack8(*(const u32x4*)(p.U + (size_t)row * 512 + c), u2);
    unpack8(*(const u32x4*)(p.P + (size_t)row * NPQ + 768 + c), bg);
    if (row < TPR) {
      const int pos = row % LP;
      if (pos >= 1) unpack8(*(const u32x4*)(p.U + (size_t)(row - 1) * 512 + c), u1); else { for (int e = 0; e < 8; ++e) u1[e] = 0.f; }
      if (pos >= 2) unpack8(*(const u32x4*)(p.U + (size_t)(row - 2) * 512 + c), u0); else { for (int e = 0; e < 8; ++e) u0[e] = 0.f; }
    } else {
      const int sb = (row - TPR) >> 2, t = (row - TPR) & 3;
      const float* st = p.state_conv + (size_t)(l * SB + sb) * 2 * 512 + c;
      if (t >= 1) unpack8(*(const u32x4*)(p.U + (size_t)(row - 1) * 512 + c), u1); else { for (int e = 0; e < 8; ++e) u1[e] = st[512 + e]; }
      if (t >= 2) unpack8(*(const u32x4*)(p.U + (size_t)(row - 2) * 512 + c), u0); else { for (int e = 0; e < 8; ++e) u0[e] = st[t * 512 + e]; }
    }
    u32x4 ov;
#pragma unroll
    for (int e = 0; e < 4; ++e) {
      const float a = bg[2 * e] * (w0[2 * e] * u0[2 * e] + w1[2 * e] * u1[2 * e] + w2[2 * e] * u2[2 * e]);
      const float bq = bg[2 * e + 1] * (w0[2 * e + 1] * u0[2 * e + 1] + w1[2 * e + 1] * u1[2 * e + 1] + w2[2 * e + 1] * u2[2 * e + 1]);
      ov[e] = pack2(a, bq);
    }
    *(u32x4*)(p.MIX + (size_t)row * D + 512 + c) = ov;
  }
}

DI void mix_phase(const Params& p, int l, char* smem, int bid, int nb, const int tid) {
  float* sBias = (float*)(smem + SM_BIAS);
  for (int i = tid; i < 8 * 129; i += NT) {
    const int hd = i / 129, d = i - hd * 129;
    int bk;
    if (d < 16) bk = d; else { bk = 16 + (int)(log2f((float)d * (1.f / 16.f)) * (16.f / 3.f) + 1e-4f); bk = min(bk, 31); }
    sBias[hd * 132 + d] = p.rel_bias[bk * 8 + hd];
  }
  __syncthreads();
  const int total = N_ATT_P + N_ATT_S + N_CONV;
  for (int it = bid; it < total; it += nb) {
    if (it < N_ATT_P + N_ATT_S) attn_item(p, l, it, smem, tid);
    else conv_item(p, l, it - (N_ATT_P + N_ATT_S), tid);
  }
  __syncthreads();
}

__global__ void __launch_bounds__(512, 2) mk_forward(Params p) {
  extern __shared__ __attribute__((aligned(16))) unsigned char lds[];
  char* smem = (char*)lds;
  const int nb = gridDim.x, bid = blockIdx.x;
  volatile LAS unsigned* xb_st = (volatile LAS unsigned*)((LAS unsigned char*)lds + 131072);
  if (threadIdx.x == 0) { xb_st[0] = 0u; xb_st[1] = 0u; xb_st[2] = 0u; xb_st[3] = 0u; }
  __syncthreads();
  const XcdBarrier xb = xcd_barrier_post(p.bar, xb_st);
  for (int ph = p.phase_lo; ph < p.phase_hi; ++ph) {
    int tid = threadIdx.x; asm volatile("" : "+v"(tid));
    if (ph == 0) { if (!(DISABLE & 1)) prep_phase(p, bid, nb, tid); }
    else {
      const int l = (ph - 1) / 10, s = (ph - 1) % 10;
      switch (s) {
        case 0: case 7: if (!(DISABLE & 2)) {
          const int f = s == 0 ? 0 : 1;
          EpiGU e{p.H};
          run_gemm(lds, p.Xb, p.Wgu + (size_t)(l * 2 + f) * 2 * DFF * D, 2 * DFF, D, e, tid);
        } break;
        case 1: case 8: if (!(DISABLE & 4)) {
          const int f = s == 1 ? 0 : 1;
          EpiRes e{p.Xf, p.Part, 0.5f};
          run_gemm_split(lds, p.H, p.Wd + (size_t)(l * 2 + f) * D * DFF, D, DFF, 11, e, tid);
        } break;
        case 2: if (!(DISABLE & 8)) ln_phase(p, l * 3 + 0, false, 11, bid, nb, tid); break;
        case 6: if (!(DISABLE & 8)) ln_phase(p, l * 3 + 1, false, 4, bid, nb, tid); break;
        case 9: if (!(DISABLE & 8)) ln_phase(p, l * 3 + 2, l == DEPTH - 1, 11, bid, nb, tid); break;
        case 3: if (!(DISABLE & 16)) {
          EpiIn e{p.P, p.U, p.out, l};
          run_gemm(lds, p.Xb, p.Win + (size_t)l * DIN * D, DIN, D, e, tid);
        } break;
        case 4: if (!(DISABLE & 32)) mix_phase(p, l, smem, bid, nb, tid); break;
        case 5: if (!(DISABLE & 64)) {
          EpiRes e{p.Xf, p.Part, 1.0f};
          run_gemm_split(lds, p.MIX, p.Wout + (size_t)l * D * D, D, D, 4, e, tid);
        } break;
      }
    }
    if (ph + 1 < p.phase_hi) {
      if (ph == 0) cg::this_grid().sync();
      else xcd_barrier(xb);
    }
#if PROBE == 2
    if (ph == 0) { for (int rep = 0; rep < 2; ++rep) { prep_phase(p, bid, nb, tid); xcd_barrier(xb); } }
#endif
#if PROBE == 3
    if (ph > 0 && (ph - 1) % 10 == 4) { for (int rep = 0; rep < 2; ++rep) { mix_phase(p, (ph - 1) / 10, smem, bid, nb, tid); xcd_barrier(xb); } }
#endif
#if PROBE == 4
    if (ph > 0 && ((ph - 1) % 10 == 0 || (ph - 1) % 10 == 7)) { const int l = (ph - 1) / 10, f = ((ph - 1) % 10 == 0) ? 0 : 1; EpiGU e{p.H}; run_gemm(lds, p.Xb, p.Wgu + (size_t)(l * 2 + f) * 2 * DFF * D, 2 * DFF, D, e, tid); xcd_barrier(xb); }
#endif
#if PROBE == 5
    if (ph > 0 && (ph - 1) % 10 == 3) { for (int rep = 0; rep < 2; ++rep) { const int l = (ph - 1) / 10; EpiIn e{p.P, p.U, p.out, l}; run_gemm(lds, p.Xb, p.Win + (size_t)l * DIN * D, DIN, D, e, tid); xcd_barrier(xb); } }
#endif
  }
#if PROBE == 1
  for (int rep = 0; rep < 80; ++rep) xcd_barrier(xb);
#endif
}

extern "C" void kernel_launch(void* const* d_in, const int* in_sizes, int n_in, void* d_out, int out_size, void* d_ws, size_t ws_size, hipStream_t stream) {
  static int grid_blocks = 0;
  if (!grid_blocks) {
    int dev = 0, cus = 0, per_cu = 0;
    (void)hipGetDevice(&dev);
    (void)hipDeviceGetAttribute(&cus, hipDeviceAttributeMultiprocessorCount, dev);
    if (hipFuncSetAttribute((const void*)mk_forward, hipFuncAttributeMaxDynamicSharedMemorySize, LDS_BYTES) != hipSuccess) fprintf(stderr, "hipFuncSetAttribute failed\n");
    (void)hipOccupancyMaxActiveBlocksPerMultiprocessor(&per_cu, mk_forward, NT, LDS_BYTES);
    if (per_cu < 1) fprintf(stderr, "occupancy query says %d blocks per CU\n", per_cu);
    grid_blocks = 256;
    if (cus != 256) fprintf(stderr, "expected 256 CUs, found %d\n", cus);
  }
  Params p{};
  p.x_prompt = (const float*)d_in[0]; p.x_sample = (const float*)d_in[1]; p.cache_k = (const float*)d_in[2]; p.cache_v = (const float*)d_in[3];
  p.state_conv = (const float*)d_in[4]; p.meta = (const float*)d_in[5]; p.rel_bias = (const float*)d_in[6]; p.w_in = (const float*)d_in[7];
  p.conv_w = (const float*)d_in[8]; p.sink = (const float*)d_in[9]; p.w_out = (const float*)d_in[10]; p.w_gate = (const float*)d_in[11];
  p.w_up = (const float*)d_in[12]; p.w_down = (const float*)d_in[13]; p.ln_g = (const float*)d_in[14]; p.ln_b = (const float*)d_in[15];
  p.out = (float*)d_out;
  char* w = (char*)d_ws; size_t off = 0;
  auto take = [&](size_t bytes) { char* q = w + off; off += (bytes + 255) & ~(size_t)255; return q; };
  p.bar = (unsigned*)take((size_t)XCD_BAR_WORDS * 4);
  p.Wgu = (bf16_t*)take((size_t)DEPTH * 2 * 2 * DFF * D * 2);
  p.Wd = (bf16_t*)take((size_t)DEPTH * 2 * D * DFF * 2);
  p.Win = (bf16_t*)take((size_t)DEPTH * DIN * D * 2);
  p.Wout = (bf16_t*)take((size_t)DEPTH * D * D * 2);
  p.Xf = (float*)take((size_t)TPAD * D * 4);
  p.Part = (float*)take((size_t)11 * SPLIT_ROWS * D * 4);
  p.Xb = (bf16_t*)take((size_t)TPAD * D * 2);
  p.H = (bf16_t*)take((size_t)TPAD * DFF * 2);
  p.P = p.H; p.U = p.P + (size_t)T * NPQ; p.MIX = p.U + (size_t)T * 512;
  const int NPH = 1 + 10 * DEPTH;
  (void)hipMemsetAsync(p.bar, 0, (size_t)XCD_BAR_WORDS * 4, stream);
#if MK_MULTI
  for (int ph = 0; ph < NPH; ++ph) {
    p.phase_lo = ph; p.phase_hi = ph + 1;
    hipLaunchKernelGGL(mk_forward, dim3(grid_blocks), dim3(NT), LDS_BYTES, stream, p);
  }
#else
  p.phase_lo = 0; p.phase_hi = NPH;
  void* args[] = {&p};
  hipError_t e = hipLaunchCooperativeKernel((void*)mk_forward, dim3(grid_blocks), dim3(NT), args, LDS_BYTES, stream);
  if (e != hipSuccess) fprintf(stderr, "cooperative launch failed: %s (grid %d)\n", hipGetErrorString(e), grid_blocks);
#endif
}
```
